# Optimizing an MI355X kernel written in HIP

```python
import jax, jax.numpy as jnp
from jax import lax
import numpy as np

D_MODEL = 2048
BATCH = 2
SEQ = 4096
DEPTH = 1
DEC_BATCH = 2
DEC_SEQ = 8192
PAST_LEN = 128

N_META = 16
GRID_W = 64
MAX_KH = 8
KW = 16
D_POOL = D_MODEL // 2
D_ATTN = D_MODEL - D_POOL
N_POOL_GROUPS = 4
POOL_WINDOWS = (2, 4, 8, 16)
POOL_GROUP_DIM = D_POOL // N_POOL_GROUPS
HEAD_DIM = 64
N_HEADS = D_ATTN // HEAD_DIM
D_FF = ((8 * D_MODEL // 3 + 127) // 128) * 128
CONV_W = 3
LN_EPS = 1e-5
RPB_ROWS = 2 * MAX_KH - 1
RPB_COLS = 2 * KW - 1
DEEPNORM_ALPHA = float((2 * DEPTH) ** 0.25)
DEEPNORM_BETA = float((8 * DEPTH) ** -0.25)

kernel_name = "hybrid_pool_natten_encoder"


def layernorm(x, g, b):
    xf = x.astype(jnp.float32)
    mu = jnp.mean(xf, axis=-1, keepdims=True)
    var = jnp.mean(jnp.square(xf - mu), axis=-1, keepdims=True)
    y = (xf - mu) * lax.rsqrt(var + LN_EPS) * g.astype(jnp.float32) + b.astype(jnp.float32)
    return y.astype(x.dtype)


def multi_scale_pool(u, w_pool, pool_scale):
    B, L, _ = u.shape
    uf = u.astype(jnp.float32)
    cs = jnp.concatenate([jnp.zeros((B, 1, D_POOL), jnp.float32), jnp.cumsum(uf, axis=1)], axis=1)
    t = jnp.arange(L)
    diffs = []
    for g, w in enumerate(POOL_WINDOWS):
        sl = slice(g * POOL_GROUP_DIM, (g + 1) * POOL_GROUP_DIM)
        lo = jnp.clip(t - w // 2, 0, L)
        hi = jnp.clip(t - w // 2 + w, 0, L)
        cnt = (hi - lo).astype(jnp.float32)[None, :, None]
        mean = (cs[:, hi, sl] - cs[:, lo, sl]) / cnt
        diffs.append(mean - uf[:, :, sl])
    m = jnp.stack(diffs, axis=2).astype(u.dtype)
    y = jnp.einsum('blgc,gce->blge', m, w_pool).reshape(B, L, D_POOL)
    return y * pool_scale


def _softmax_split(s_loc, s_meta):
    n_loc = s_loc.shape[-1]
    p = jax.nn.softmax(jnp.concatenate([s_loc, s_meta], axis=-1), axis=-1)
    return p[..., :n_loc], p[..., n_loc:]


def neighbourhood_attention(q, k, v, rpb, meta_bias):
    B, L, H, Dh = q.shape
    T = L - N_META
    rows = T // GRID_W
    kh = min(MAX_KH, rows)
    scale = HEAD_DIM ** -0.5
    f32 = jnp.float32
    rpb = rpb.astype(f32)
    meta_b = meta_bias.astype(f32)[None, :, None, :]

    qm, km, vm = q[:, :N_META], k[:, :N_META], v[:, :N_META]
    qg = q[:, N_META:].reshape(B, rows, GRID_W, H, Dh)
    kg = k[:, N_META:].reshape(B, rows, GRID_W, H, Dh)
    vg = v[:, N_META:].reshape(B, rows, GRID_W, H, Dh)

    cols = jnp.arange(GRID_W)
    col_start = jnp.clip(cols - KW // 2, 0, GRID_W - KW)
    col_idx = col_start[:, None] + jnp.arange(KW)[None, :]
    dc_idx = col_idx - cols[:, None] + (KW - 1)

    def row_block(r):
        rs = jnp.clip(r - kh // 2, 0, rows - kh)
        k_rows = lax.dynamic_slice_in_dim(kg, rs, kh, axis=1)
        v_rows = lax.dynamic_slice_in_dim(vg, rs, kh, axis=1)
        k_win = k_rows[:, :, col_idx]
        v_win = v_rows[:, :, col_idx]
        q_row = lax.dynamic_index_in_dim(qg, r, axis=1, keepdims=False)
        dr_idx = rs + jnp.arange(kh) - r + (MAX_KH - 1)
        bias = rpb[:, dr_idx[None, :, None], dc_idx[:, None, :]]
        s_loc = jnp.einsum('bchd,bkcwhd->bhckw', q_row, k_win).astype(f32) * scale + bias[None]
        s_meta = jnp.einsum('bchd,bmhd->bhcm', q_row, km).astype(f32) * scale + meta_b
        p_loc, p_meta = _softmax_split(s_loc.reshape(B, H, GRID_W, kh * KW), s_meta)
        p_loc = p_loc.reshape(B, H, GRID_W, kh, KW).astype(v.dtype)
        out = (jnp.einsum('bhckw,bkcwhd->bchd', p_loc, v_win)
               + jnp.einsum('bhcm,bmhd->bchd', p_meta.astype(v.dtype), vm))
        return out

    y_grid = lax.map(row_block, jnp.arange(rows))
    y_grid = jnp.moveaxis(y_grid, 0, 1).reshape(B, T, H, Dh)

    k0 = kg[:, :kh, :KW]
    v0 = vg[:, :kh, :KW]
    bias0 = rpb[:, (MAX_KH - 1) + jnp.arange(kh)][:, :, (KW - 1) + jnp.arange(KW)]
    s_loc0 = jnp.einsum('bmhd,bkwhd->bhmkw', qm, k0).astype(f32) * scale + bias0[None, :, None]
    s_meta0 = jnp.einsum('bmhd,bnhd->bhmn', qm, km).astype(f32) * scale + meta_b
    p_loc0, p_meta0 = _softmax_split(s_loc0.reshape(B, H, N_META, kh * KW), s_meta0)
    p_loc0 = p_loc0.reshape(B, H, N_META, kh, KW).astype(v.dtype)
    y_meta = (jnp.einsum('bhmkw,bkwhd->bmhd', p_loc0, v0)
              + jnp.einsum('bhmn,bnhd->bmhd', p_meta0.astype(v.dtype), vm))
    return jnp.concatenate([y_meta, y_grid], axis=1)


def conv_gated_ffn(h, w_up, b_up, conv_w, conv_b, w_down):
    z = h @ w_up + b_up
    zp = jnp.pad(z, ((0, 0), (1, 1), (0, 0)))
    z = zp[:, :-2] * conv_w[0] + zp[:, 1:-1] * conv_w[1] + zp[:, 2:] * conv_w[2] + conv_b
    a, g = jnp.split(z, 2, axis=-1)
    return (a * jax.nn.gelu(g, approximate=False)) @ w_down


def encode(x, meta_tokens, ln_in_g, ln_in_b, w_in, w_pool, pool_scale, rpb, meta_bias,
           w_out, ln1_g, ln1_b, w_up, b_up, conv_w, conv_b, w_down, ln2_g, ln2_b):
    B, T, D = x.shape
    meta = jnp.broadcast_to(meta_tokens[None].astype(x.dtype), (B, N_META, D))
    h = layernorm(jnp.concatenate([meta, x], axis=1), ln_in_g, ln_in_b)
    L = h.shape[1]
    for l in range(DEPTH):
        proj = h @ w_in[l]
        u = proj[..., :D_POOL]
        q = proj[..., D_POOL:D_POOL + D_ATTN].reshape(B, L, N_HEADS, HEAD_DIM)
        k = proj[..., D_POOL + D_ATTN:D_POOL + 2 * D_ATTN].reshape(B, L, N_HEADS, HEAD_DIM)
        v = proj[..., D_POOL + 2 * D_ATTN:].reshape(B, L, N_HEADS, HEAD_DIM)
        y_pool = multi_scale_pool(u, w_pool[l], pool_scale[l])
        y_attn = neighbourhood_attention(q, k, v, rpb[l], meta_bias[l]).reshape(B, L, D_ATTN)
        mix = jnp.concatenate([y_pool, y_attn], axis=-1) @ w_out[l]
        h = layernorm(DEEPNORM_ALPHA * h + mix, ln1_g[l], ln1_b[l])
        ffn = conv_gated_ffn(h, w_up[l], b_up[l], conv_w[l], conv_b[l], w_down[l])
        h = layernorm(DEEPNORM_ALPHA * h + ffn, ln2_g[l], ln2_b[l])
    return h[:, N_META:]


def setup_inputs(seed: int = 0) -> dict:
    key = jax.random.key(seed)
    ks = jax.random.split(key, 20)
    f32 = jnp.float32

    def nrm(k, shape, s):
        return jax.random.normal(k, shape, f32) * s

    n_in = D_POOL + 3 * D_ATTN
    col_scale = jnp.concatenate([jnp.ones((D_POOL + 2 * D_ATTN,), f32),
                                 jnp.full((D_ATTN,), DEEPNORM_BETA, f32)])
    return {
        "x_prompt": nrm(ks[0], (BATCH, SEQ, D_MODEL), 1.0),
        "x_sample": nrm(ks[1], (DEC_BATCH, DEC_SEQ, D_MODEL), 1.0),
        "meta_tokens": nrm(ks[2], (N_META, D_MODEL), 1.0),
        "ln_in_g": 1.0 + nrm(ks[3], (D_MODEL,), 0.02),
        "ln_in_b": nrm(ks[4], (D_MODEL,), 0.02),
        "w_in": nrm(ks[5], (DEPTH, D_MODEL, n_in), D_MODEL ** -0.5) * col_scale,
        "w_pool": nrm(ks[6], (DEPTH, N_POOL_GROUPS, POOL_GROUP_DIM, POOL_GROUP_DIM), POOL_GROUP_DIM ** -0.5),
        "pool_scale": 1.0 + nrm(ks[7], (DEPTH, D_POOL), 0.02),
        "rpb": nrm(ks[8], (DEPTH, N_HEADS, RPB_ROWS, RPB_COLS), 0.1),
        "meta_bias": nrm(ks[9], (DEPTH, N_HEADS, N_META), 0.1),
        "w_out": nrm(ks[10], (DEPTH, D_POOL + D_ATTN, D_MODEL), (D_POOL + D_ATTN) ** -0.5 * DEEPNORM_BETA),
        "ln1_g": 1.0 + nrm(ks[11], (DEPTH, D_MODEL), 0.02),
        "ln1_b": nrm(ks[12], (DEPTH, D_MODEL), 0.02),
        "w_up": nrm(ks[13], (DEPTH, D_MODEL, 2 * D_FF), D_MODEL ** -0.5),
        "b_up": nrm(ks[14], (DEPTH, 2 * D_FF), 0.01),
        "conv_w": nrm(ks[15], (DEPTH, CONV_W, 2 * D_FF), CONV_W ** -0.5),
        "conv_b": nrm(ks[16], (DEPTH, 2 * D_FF), 0.01),
        "w_down": nrm(ks[17], (DEPTH, D_FF, D_MODEL), D_FF ** -0.5 * DEEPNORM_BETA),
        "ln2_g": 1.0 + nrm(ks[18], (DEPTH, D_MODEL), 0.02),
        "ln2_b": nrm(ks[19], (DEPTH, D_MODEL), 0.02),
    }


def reference(x_prompt, x_sample, meta_tokens, ln_in_g, ln_in_b, w_in, w_pool, pool_scale, rpb,
              meta_bias, w_out, ln1_g, ln1_b, w_up, b_up, conv_w, conv_b, w_down, ln2_g, ln2_b):
    y_prompt = encode(x_prompt, meta_tokens, ln_in_g, ln_in_b, w_in, w_pool, pool_scale, rpb,
                      meta_bias, w_out, ln1_g, ln1_b, w_up, b_up, conv_w, conv_b, w_down, ln2_g, ln2_b)
    y_sample = encode(x_sample, meta_tokens, ln_in_g, ln_in_b, w_in, w_pool, pool_scale, rpb,
                      meta_bias, w_out, ln1_g, ln1_b, w_up, b_up, conv_w, conv_b, w_down, ln2_g, ln2_b)
    return (y_prompt, y_sample)
```

```cpp
#include <hip/hip_runtime.h>
#include <hip/hip_cooperative_groups.h>
#include <cstdio>
#include <cstdint>
namespace cg = cooperative_groups;

constexpr int DM = 2048, NIN = 4096, DFF = 5504, NUP = 2 * DFF;
constexpr int R_TOT = 24640;
constexpr int G_TOT = 24576;
constexpr float LN_EPS = 1e-5f;
constexpr float ALPHA = 1.189207115002721f;
__device__ __forceinline__ int seq_of_row(int R) { return (R >= 4112) + (R >= 8224) + (R >= 16432); }
__device__ __forceinline__ int seq_start(int s) { return s == 0 ? 0 : s == 1 ? 4112 : s == 2 ? 8224 : 16432; }
__device__ __forceinline__ int seq_len(int s) { return s < 2 ? 4112 : 8208; }
__device__ __forceinline__ int grid_start(int s) { return s == 0 ? 0 : s == 1 ? 4096 : s == 2 ? 8192 : 16384; }

constexpr size_t MiB = 1u << 20;
constexpr size_t WS_WIN = 0, WS_WOUT = 16 * MiB, WS_WUP = 24 * MiB, WS_WDN = 67 * MiB, WS_SIDE = 89 * MiB;
constexpr size_t WS_H1 = 90 * MiB + 4096;
constexpr size_t WS_H0 = 189 * MiB, WS_PROJ = 287 * MiB, WS_ACT = 189 * MiB, WS_END = 481 * MiB;

constexpr int LDS_BYTES = 147456;
constexpr int XCH_OFF = 131072;
namespace pg8 {
#define PG8_LAS __attribute__((address_space(3)))
typedef unsigned short bf16_t;
typedef short bf16x8 __attribute__((ext_vector_type(8)));
typedef float f32x4 __attribute__((ext_vector_type(4)));
typedef unsigned u32x4 __attribute__((ext_vector_type(4)));
constexpr int BM = 256, BK = 64, HALF = 128, HTB = HALF * BK * 2  , STAGE_BYTES = 8 * HTB, NXCD = 8, WGM = 8;

__host__ __device__ __forceinline__ int lds_byte(int r, int c) { const int st = (r >> 4) * 2 + (c >> 5), rr = r & 15, cc = c & 31, ob = rr * 64 + cc * 2; return st * 1024 + (ob ^ (((ob >> 9) & 1) << 5)); }
__host__ __device__ __forceinline__ void stage_rc(int b, int& R, int& C) { const int st = b / 1024, sb = b % 1024, swz = sb ^ (((sb >> 9) & 1) << 5); R = (st >> 1) * 16 + swz / 64; C = (st & 1) * 32 + (swz % 64) / 2; }
__host__ __device__ __forceinline__ int perm32(int rho) { const int n = rho >> 4, i = rho & 15; return 8 * (i >> 2) + 4 * n + (i & 3); }

struct Unit { int pm, pn; };
struct Gemm { const bf16_t* A; const bf16_t* Bt; int M, N, K; };

struct StaticOrder {
    int nM, nN, nwg, G, c;
    __host__ __device__ void init(int M, int N, int G_, int c_) { nM = M / BM; nN = N / BM; nwg = nM * nN; G = G_; c = c_; }
    __host__ __device__ bool next(int i, Unit& u) const {
        const long L = (long)i * G + c; if (L >= nwg) return false;
        int wgid = (int)L; { const int q = nwg / NXCD, r = nwg % NXCD, xcd = wgid % NXCD, off = wgid / NXCD; wgid = (xcd < r ? xcd * (q + 1) : r * (q + 1) + (xcd - r) * q) + off; }
        const int nig = WGM * nN, gid = wgid / nig, fm = gid * WGM, gsz = (nM - fm) < WGM ? (nM - fm) : WGM;
        u.pm = fm + ((wgid % nig) % gsz); u.pn = (wgid % nig) / gsz; return true;
    }
    __device__ __forceinline__ void a_ready(const Unit&) const {}
    __device__ __forceinline__ void done(const Unit&) const {}
};

__device__ __forceinline__ unsigned cvt_pk_bf16(float lo, float hi) { unsigned r; asm volatile("v_cvt_pk_bf16_f32 %0, %1, %2" : "=v"(r) : "v"(lo), "v"(hi)); return r; }
typedef float f32x2 __attribute__((ext_vector_type(2)));
__device__ __forceinline__ f32x2 gelu_pk(f32x2 v) {
    const f32x2 av = __builtin_elementwise_abs(v), d = av * 0.2316418882f + 1.0f;
    f32x2 t; t.x = __builtin_amdgcn_rcpf(d.x); t.y = __builtin_amdgcn_rcpf(d.y);
    f32x2 q = t * 0.5307027145f + (-0.7265760135f); q = q * t + 0.7107068705f; q = q * t + (-0.142248368f); q = q * t + 0.127414796f; q = q * t;
    const f32x2 s = (v * v) * (-0.72134752044f);
    f32x2 e; e.x = __builtin_amdgcn_exp2f(s.x); e.y = __builtin_amdgcn_exp2f(s.y);
    const f32x2 m = v * (q * e), r = v - m;
    f32x2 o; o.x = v.x < 0.f ? m.x : r.x; o.y = v.y < 0.f ? m.y : r.y; return o;
}

struct RMNat  { static __device__ __forceinline__ int arow(int pm) { return pm * 256; } };
struct RMUp   { static __device__ __forceinline__ int arow(int pm) { return pm * 254 - 1; } };
struct RMGrid { static __device__ __forceinline__ int arow(int pm) { return pm * 256 + 16 * (1 + (pm >= 16) + (pm >= 32) + (pm >= 64)); } };

__device__ __forceinline__ float bf2f(unsigned short b) { return __uint_as_float((unsigned)b << 16); }

struct EpiBf16 {
    static constexpr bool PERM = true, AFTER_DRAIN = false;
    bf16_t* O; int ldc;
    __device__ __forceinline__ void operator()(const f32x4 (&acc)[2][2][4][2], const Unit& u, int wr, int wc, int fr, int fq) const {
        const int row0 = u.pm * BM + wr * 64 + fr; const int col0 = u.pn * BM + wc * 32 + 8 * fq;
#pragma unroll
        for (int ai = 0; ai < 2; ++ai)
#pragma unroll
            for (int m = 0; m < 4; ++m) { bf16_t* rowp = O + (size_t)(row0 + ai * HALF + m * 16) * ldc + col0;
#pragma unroll
                for (int bj = 0; bj < 2; ++bj) { const f32x4 v0 = acc[ai][bj][m][0], v1 = acc[ai][bj][m][1];
                    u32x4 w; w.x = cvt_pk_bf16(v0[0], v0[1]); w.y = cvt_pk_bf16(v0[2], v0[3]); w.z = cvt_pk_bf16(v1[0], v1[1]); w.w = cvt_pk_bf16(v1[2], v1[3]);
                    *(u32x4*)(rowp + bj * HALF) = w; } }
    }
};

template <int MODE> struct EpiRes {
    static constexpr bool PERM = true, AFTER_DRAIN = false;
    const bf16_t* Hres; float* out; float* side;
    __device__ __forceinline__ void operator()(const f32x4 (&acc)[2][2][4][2], const Unit& u, int wr, int wc, int fr, int fq) const {
        const int col0 = u.pn * BM + wc * 32 + 8 * fq;
#pragma unroll
        for (int ai = 0; ai < 2; ++ai)
#pragma unroll
            for (int m = 0; m < 4; ++m) {
                const int r = ai * HALF + wr * 64 + m * 16 + fr;
                float* dst; const bf16_t* res; bool ok = true;
                if (MODE == 0) { const int R = u.pm * BM + r; ok = R < R_TOT; const int s = seq_of_row(R), t = R - seq_start(s);
                    dst = (t < 16) ? side + (size_t)(s * 16 + t) * DM : out + (size_t)(grid_start(s) + t - 16) * DM; res = Hres + (size_t)R * DM; }
                else { dst = out + (size_t)(u.pm * BM + r) * DM; res = Hres + (size_t)(RMGrid::arow(u.pm) + r) * DM; }
                if (ok) {
#pragma unroll
                    for (int bj = 0; bj < 2; ++bj) {
                        const u32x4 hv = *(const u32x4*)(res + col0 + bj * HALF);
                        f32x4 h0, h1;
                        h0[0] = __uint_as_float(hv.x << 16); h0[1] = __uint_as_float(hv.x & 0xffff0000u); h0[2] = __uint_as_float(hv.y << 16); h0[3] = __uint_as_float(hv.y & 0xffff0000u);
                        h1[0] = __uint_as_float(hv.z << 16); h1[1] = __uint_as_float(hv.z & 0xffff0000u); h1[2] = __uint_as_float(hv.w << 16); h1[3] = __uint_as_float(hv.w & 0xffff0000u);
                        *(f32x4*)(dst + col0 + bj * HALF) = acc[ai][bj][m][0] + h0 * ALPHA;
                        *(f32x4*)(dst + col0 + bj * HALF + 4) = acc[ai][bj][m][1] + h1 * ALPHA; } }
            }
    }
};

__device__ __forceinline__ float dppf(float old, float src, const int ctrl_sel) {
    const int o = __float_as_int(old), s = __float_as_int(src); int r;
    if (ctrl_sel == 0) r = __builtin_amdgcn_update_dpp(o, s, 0x111, 0xf, 0xf, false);
    else if (ctrl_sel == 1) r = __builtin_amdgcn_update_dpp(o, s, 0x101, 0xf, 0xf, false);
    else if (ctrl_sel == 2) r = __builtin_amdgcn_update_dpp(o, s, 0x121, 0xf, 0xf, false);
    else r = __builtin_amdgcn_update_dpp(o, s, 0x12f, 0xf, 0xf, false);
    return __int_as_float(r);
}
struct EpiConvGate {
    static constexpr bool PERM = true, AFTER_DRAIN = false;
    bf16_t* ACT; const float* b_up; const float* conv_w; const float* conv_b; PG8_LAS float* X;
    __device__ __forceinline__ void operator()(f32x4 (&acc)[2][2][4][2], const Unit& u, int wr, int wc, int fr, int fq) const {
        const int lc0 = wc * 32 + 8 * fq, ca0 = u.pn * HALF + lc0;
#pragma unroll
        for (int bj = 0; bj < 2; ++bj)
#pragma unroll
            for (int n = 0; n < 2; ++n) { const f32x4 bv = *(const f32x4*)(b_up + bj * DFF + ca0 + 4 * n);
#pragma unroll
                for (int ai = 0; ai < 2; ++ai)
#pragma unroll
                    for (int m = 0; m < 4; ++m) acc[ai][bj][m][n] += bv; }
        if (fr == 0) {
#pragma unroll
            for (int ai = 0; ai < 2; ++ai)
#pragma unroll
                for (int bj = 0; bj < 2; ++bj)
#pragma unroll
                    for (int n = 0; n < 2; ++n) *(PG8_LAS f32x4*)(X + (((ai * 2 + wr) * 2 + 0) * 256 + bj * HALF + lc0 + 4 * n)) = acc[ai][bj][0][n];
        }
        if (fr == 15) {
#pragma unroll
            for (int ai = 0; ai < 2; ++ai)
#pragma unroll
                for (int bj = 0; bj < 2; ++bj)
#pragma unroll
                    for (int n = 0; n < 2; ++n) *(PG8_LAS f32x4*)(X + (((ai * 2 + wr) * 2 + 1) * 256 + bj * HALF + lc0 + 4 * n)) = acc[ai][bj][3][n];
        }
        asm volatile("s_waitcnt lgkmcnt(0)" ::: "memory"); __builtin_amdgcn_s_barrier(); asm volatile("" ::: "memory");
        const int Rt = 254 * u.pm - 1;
#pragma unroll
        for (int n = 0; n < 2; ++n) {
            f32x4 w0[2], w1[2], w2[2], cbv[2];
#pragma unroll
            for (int bj = 0; bj < 2; ++bj) { const int ch = bj * DFF + ca0 + 4 * n;
                w0[bj] = *(const f32x4*)(conv_w + ch); w1[bj] = *(const f32x4*)(conv_w + NUP + ch); w2[bj] = *(const f32x4*)(conv_w + 2 * NUP + ch); cbv[bj] = *(const f32x4*)(conv_b + ch); }
#pragma unroll
            for (int ai = 0; ai < 2; ++ai)
#pragma unroll
                for (int m = 0; m < 4; ++m) {
                    const int r = ai * HALF + wr * 64 + m * 16 + fr, R = Rt + r;
                    const bool zp = (R == 0) | (R == 4112) | (R == 8224) | (R == 16432);
                    const bool zn = (R == 4111) | (R == 8223) | (R == 16431) | (R == 24639);
                    f32x4 z[2];
#pragma unroll
                    for (int bj = 0; bj < 2; ++bj) {
                        const f32x4 cur = acc[ai][bj][m][n]; f32x4 ep, en;
                        const int chk = ai * 2 + wr;
                        if (m > 0) { const f32x4 pb = acc[ai][bj][m > 0 ? m - 1 : 0][n];
#pragma unroll
                            for (int e = 0; e < 4; ++e) ep[e] = dppf(0.f, pb[e], 2); }
                        else { const int pc = chk > 0 ? chk - 1 : 0; ep = *(const PG8_LAS f32x4*)(X + ((pc * 2 + 1) * 256 + bj * HALF + lc0 + 4 * n)); }
                        if (m < 3) { const f32x4 nb = acc[ai][bj][m < 3 ? m + 1 : 3][n];
#pragma unroll
                            for (int e = 0; e < 4; ++e) en[e] = dppf(0.f, nb[e], 3); }
                        else { const int nc = chk < 3 ? chk + 1 : 3; en = *(const PG8_LAS f32x4*)(X + ((nc * 2 + 0) * 256 + bj * HALF + lc0 + 4 * n)); }
                        f32x4 pv, nv;
#pragma unroll
                        for (int e = 0; e < 4; ++e) { pv[e] = dppf(ep[e], cur[e], 0); nv[e] = dppf(en[e], cur[e], 1); pv[e] = zp ? 0.f : pv[e]; nv[e] = zn ? 0.f : nv[e]; }
                        z[bj] = w0[bj] * pv + w1[bj] * cur + w2[bj] * nv + cbv[bj];
                    }
                    const f32x2 g0 = gelu_pk((f32x2){z[1][0], z[1][1]}), g1 = gelu_pk((f32x2){z[1][2], z[1][3]});
                    unsigned o0 = cvt_pk_bf16(z[0][0] * g0.x, z[0][1] * g0.y), o1 = cvt_pk_bf16(z[0][2] * g1.x, z[0][3] * g1.y);
                    if (r >= 1 && r <= 254 && R < R_TOT) { typedef unsigned u32x2v __attribute__((ext_vector_type(2))); u32x2v w; w.x = o0; w.y = o1;
                        *(u32x2v*)(ACT + (size_t)R * DFF + ca0 + 4 * n) = w; }
                }
        }
    }
};

template <class Epi, class RM, class Sched, bool ALIGN_EPI = false, bool SP2 = false>
__device__ __forceinline__ void gemm_phase(PG8_LAS unsigned char* lds, const Gemm g, const Sched& S, const Epi& E) {
    const int tid = threadIdx.x, wid = __builtin_amdgcn_readfirstlane(tid >> 6), lane = tid & 63, wr = wid >> 2, wc = wid & 3, fr = lane & 15, fq = lane >> 4;
    const int K = g.K, nt = K / BK;
    unsigned voffA[2], voffB[2];
#pragma unroll
    for (int i = 0; i < 2; ++i) { int R, C; stage_rc(tid * 16 + i * 8192, R, C); const int Rb = Epi::PERM ? ((R & ~31) + perm32(R & 31)) : R;
        voffA[i] = (unsigned)(R * K + C) * 2u; voffB[i] = (unsigned)(Rb * K + C) * 2u; }
    const size_t kstep = (size_t)(BK * 2);
    const size_t hstep = (size_t)HALF * K * 2;
    const size_t tstep = 2 * hstep; const ptrdiff_t rowb = (ptrdiff_t)K * 2;
    const unsigned ldsw = (unsigned)wid * 1024u;
    const int aoff = lds_byte(wr * 64 + fr, fq * 8), boff = lds_byte(wc * 32 + fr, fq * 8);
#define PG8_SA(b, h) (((b) * 2 + (h)) * HTB)
#define PG8_SB(b, h) ((4 + (b) * 2 + (h)) * HTB)
#define PG8_STAGE(bufoff, gbase, voff) do { _Pragma("unroll") for (int _i = 0; _i < 2; ++_i) \
        __builtin_amdgcn_global_load_lds((const unsigned*)((const char*)(gbase) + (voff)[_i]), (PG8_LAS unsigned*)(lds + (bufoff) + ldsw + _i * 8192), 16, 0, 0); } while (0)
#define PG8_LDA(dst, b, h) do { _Pragma("unroll") for (int m = 0; m < 4; ++m) _Pragma("unroll") for (int k = 0; k < 2; ++k) dst[m][k] = *(const PG8_LAS bf16x8*)(lds + PG8_SA(b, h) + aoff + m * 2048 + k * 1024); } while (0)
#define PG8_LDB(dst, b, h) do { _Pragma("unroll") for (int n = 0; n < 2; ++n) _Pragma("unroll") for (int k = 0; k < 2; ++k) dst[n][k] = *(const PG8_LAS bf16x8*)(lds + PG8_SB(b, h) + boff + n * 2048 + k * 1024); } while (0)
#define PG8_MMA(ai, bj, At, Bt) do { __builtin_amdgcn_s_setprio(1); _Pragma("unroll") for (int m = 0; m < 4; ++m) _Pragma("unroll") for (int n = 0; n < 2; ++n) _Pragma("unroll") for (int k = 0; k < 2; ++k) \
        acc[ai][bj][m][n] = __builtin_amdgcn_mfma_f32_16x16x32_bf16(Bt[n][k], At[m][k], acc[ai][bj][m][n], 0, 0, 0); __builtin_amdgcn_s_setprio(0); } while (0)
#define PG8_WAIT_V(n) asm volatile("s_waitcnt vmcnt(" #n ")" ::: "memory")
#define PG8_WAIT_L(n) asm volatile("s_waitcnt lgkmcnt(" #n ")" ::: "memory")
#define PG8_BAR __builtin_amdgcn_s_barrier()
#define PG8_SCHED __builtin_amdgcn_sched_barrier(0)
    Unit cur, nxt; int ui = 0;
    if (!S.next(0, cur)) return;
    f32x4 acc[2][2][4][2];
#pragma unroll
    for (int a = 0; a < 2; ++a)
#pragma unroll
        for (int b = 0; b < 2; ++b)
#pragma unroll
            for (int m = 0; m < 4; ++m)
#pragma unroll
                for (int n = 0; n < 2; ++n) acc[a][b][m][n] = (f32x4){0.f, 0.f, 0.f, 0.f};
    bf16x8 At[4][2], B0[2][2], B1[2][2];
    const char* cA = (const char*)g.A + (ptrdiff_t)RM::arow(cur.pm) * rowb; const char* cB = (const char*)g.Bt + (size_t)cur.pn * tstep;
    S.a_ready(cur);
    if constexpr (SP2) {
        PG8_STAGE(PG8_SB(0, 0), cB, voffB); PG8_STAGE(PG8_SB(0, 1), cB + hstep, voffB); PG8_STAGE(PG8_SA(0, 0), cA, voffA); PG8_STAGE(PG8_SA(0, 1), cA + hstep, voffA);
        if (wr == 1) PG8_BAR;
        PG8_WAIT_V(2); PG8_BAR;
        PG8_STAGE(PG8_SB(1, 0), cB + kstep, voffB); PG8_STAGE(PG8_SA(1, 0), cA + kstep, voffA); PG8_STAGE(PG8_SB(1, 1), cB + hstep + kstep, voffB);
        PG8_WAIT_V(6); PG8_BAR;
    } else {
        PG8_STAGE(PG8_SB(0, 0), cB, voffB); PG8_STAGE(PG8_SA(0, 0), cA, voffA); PG8_STAGE(PG8_SB(0, 1), cB + hstep, voffB); PG8_STAGE(PG8_SA(0, 1), cA + hstep, voffA);
        if (wr == 1) PG8_BAR;
        PG8_WAIT_V(4); PG8_BAR;
        PG8_STAGE(PG8_SB(1, 0), cB + kstep, voffB); PG8_STAGE(PG8_SA(1, 0), cA + kstep, voffA); PG8_STAGE(PG8_SB(1, 1), cB + hstep + kstep, voffB);
        PG8_WAIT_V(6); PG8_BAR;
    }
    for (;;) {
        const bool has_next = S.next(ui + 1, nxt);
        const char* nA = has_next ? (const char*)g.A + (ptrdiff_t)RM::arow(nxt.pm) * rowb : cA; const char* nB = has_next ? (const char*)g.Bt + (size_t)nxt.pn * tstep : cB;
        for (int t = 0; t < nt; t += 2) {
            const bool last = (t == nt - 2);
            const char* a1 = cA + (size_t)(t + 1) * kstep;
            const char* a2 = last ? nA : cA + (size_t)(t + 2) * kstep; const char* b2 = last ? nB : cB + (size_t)(t + 2) * kstep;
            const char* a3 = a2 + kstep; const char* b3 = b2 + kstep;
            if (last && has_next) S.a_ready(nxt);
            if constexpr (SP2) {
            PG8_LDB(B0, 0, 0); PG8_LDB(B1, 0, 1); PG8_SCHED; PG8_LDA(At, 0, 0); PG8_STAGE(PG8_SA(1, 1), a1 + hstep, voffA);
            PG8_WAIT_V(8); PG8_WAIT_L(0); PG8_BAR; PG8_MMA(0, 0, At, B0); PG8_MMA(0, 1, At, B1); PG8_BAR; PG8_SCHED;
            PG8_LDA(At, 0, 1); PG8_STAGE(PG8_SB(0, 0), b2, voffB); PG8_STAGE(PG8_SB(0, 1), b2 + hstep, voffB); PG8_STAGE(PG8_SA(0, 0), a2, voffA);
            PG8_WAIT_V(8); PG8_WAIT_L(0); PG8_BAR; PG8_MMA(1, 0, At, B0); PG8_MMA(1, 1, At, B1); PG8_BAR; PG8_SCHED;
            PG8_LDB(B0, 1, 0); PG8_LDB(B1, 1, 1); PG8_SCHED; PG8_LDA(At, 1, 0); PG8_STAGE(PG8_SA(0, 1), a2 + hstep, voffA);
            PG8_WAIT_V(8); PG8_WAIT_L(0); PG8_BAR; PG8_MMA(0, 0, At, B0); PG8_MMA(0, 1, At, B1); PG8_BAR; PG8_SCHED;
            PG8_LDA(At, 1, 1); PG8_STAGE(PG8_SB(1, 0), b3, voffB); PG8_STAGE(PG8_SB(1, 1), b3 + hstep, voffB); PG8_STAGE(PG8_SA(1, 0), a3, voffA);
            PG8_WAIT_V(8); PG8_WAIT_L(0); PG8_BAR; PG8_MMA(1, 0, At, B0); PG8_MMA(1, 1, At, B1); PG8_BAR; PG8_SCHED;
            } else {
            PG8_LDB(B0, 0, 0); PG8_SCHED; PG8_LDA(At, 0, 0); PG8_STAGE(PG8_SA(1, 1), a1 + hstep, voffA);
            PG8_WAIT_L(8); PG8_BAR; PG8_WAIT_L(0); PG8_MMA(0, 0, At, B0); PG8_BAR; PG8_SCHED;
            PG8_LDB(B1, 0, 1); PG8_STAGE(PG8_SB(0, 0), b2, voffB);
            PG8_BAR; PG8_WAIT_L(0); PG8_MMA(0, 1, At, B1); PG8_BAR;
            PG8_LDA(At, 0, 1); PG8_STAGE(PG8_SA(0, 0), a2, voffA);
            PG8_BAR; PG8_WAIT_L(0); PG8_MMA(1, 0, At, B0); PG8_BAR; PG8_SCHED;
            PG8_STAGE(PG8_SB(0, 1), b2 + hstep, voffB);
            PG8_WAIT_V(6); PG8_BAR; PG8_MMA(1, 1, At, B1); PG8_BAR;
            PG8_LDB(B0, 1, 0); PG8_SCHED; PG8_LDA(At, 1, 0); PG8_STAGE(PG8_SA(0, 1), a2 + hstep, voffA);
            PG8_WAIT_L(8); PG8_BAR; PG8_WAIT_L(0); PG8_MMA(0, 0, At, B0); PG8_BAR; PG8_SCHED;
            PG8_LDB(B1, 1, 1); PG8_STAGE(PG8_SB(1, 0), b3, voffB);
            PG8_BAR; PG8_WAIT_L(0); PG8_MMA(0, 1, At, B1); PG8_BAR;
            PG8_LDA(At, 1, 1); PG8_STAGE(PG8_SA(1, 0), a3, voffA);
            PG8_BAR; PG8_WAIT_L(0); PG8_MMA(1, 0, At, B0); PG8_BAR; PG8_SCHED;
            PG8_STAGE(PG8_SB(1, 1), b3 + hstep, voffB);
            PG8_WAIT_V(6); PG8_BAR; PG8_MMA(1, 1, At, B1); PG8_BAR;
            }
        }
        if constexpr (ALIGN_EPI) { if (wr == 0) PG8_BAR; }
        if constexpr (!Epi::AFTER_DRAIN) { E(acc, cur, wr, wc, fr, fq); S.done(cur); }
        if (!has_next) break;
#pragma unroll
        for (int a = 0; a < 2; ++a)
#pragma unroll
            for (int b = 0; b < 2; ++b)
#pragma unroll
                for (int m = 0; m < 4; ++m)
#pragma unroll
                    for (int n = 0; n < 2; ++n) acc[a][b][m][n] = (f32x4){0.f, 0.f, 0.f, 0.f};
        cur = nxt; cA = nA; cB = nB; ++ui;
        if constexpr (ALIGN_EPI) { if (wr == 1) PG8_BAR; }
    }
    PG8_WAIT_V(0);
    if constexpr (!ALIGN_EPI) { if (wr == 0) PG8_BAR; }
    PG8_BAR;
    if constexpr (Epi::AFTER_DRAIN) { E.fused(acc, cur, wr, wc, fr, fq, lds, wid, lane); S.done(cur); }
#undef PG8_SA
#undef PG8_SB
#undef PG8_STAGE
#undef PG8_LDA
#undef PG8_LDB
#undef PG8_MMA
#undef PG8_WAIT_V
#undef PG8_WAIT_L
#undef PG8_BAR
#undef PG8_SCHED
}
}
#define LAS __attribute__((address_space(3)))
typedef unsigned short bf16;
typedef float f32x4 __attribute__((ext_vector_type(4)));
typedef short bf16x8 __attribute__((ext_vector_type(8)));
typedef unsigned u32x4 __attribute__((ext_vector_type(4)));
typedef unsigned u32x2 __attribute__((ext_vector_type(2)));
#define LDS_WAIT() asm volatile("s_waitcnt lgkmcnt(0)" ::: "memory")
__device__ __forceinline__ unsigned pk2(float lo, float hi) { return pg8::cvt_pk_bf16(lo, hi); }

struct Args {
    const float *x_prompt, *x_sample, *meta_tokens, *ln_in_g, *ln_in_b, *w_in, *w_pool, *pool_scale, *rpb, *meta_bias, *w_out, *ln1_g, *ln1_b,
                *w_up, *b_up, *conv_w, *conv_b, *w_down, *ln2_g, *ln2_b;
    float* out; unsigned char* ws;
};

__device__ __forceinline__ float wave_sum(float v) {
#pragma unroll
    for (int o = 1; o < 64; o <<= 1) v += __shfl_xor(v, o);
    return v;
}
template <bool OUT_BF16> __device__ __forceinline__ void ln_row(const float* src, const float* g, const float* b, void* dst, int lane) {
    const f32x4* xr = (const f32x4*)src + lane;
    f32x4 v[8]; float s = 0.f;
#pragma unroll
    for (int j = 0; j < 8; ++j) { v[j] = xr[64 * j]; s += (v[j][0] + v[j][1]) + (v[j][2] + v[j][3]); }
    const float mean = wave_sum(s) * (1.f / DM); float s2 = 0.f;
#pragma unroll
    for (int j = 0; j < 8; ++j) { v[j] = v[j] - mean; s2 += (v[j][0] * v[j][0] + v[j][1] * v[j][1]) + (v[j][2] * v[j][2] + v[j][3] * v[j][3]); }
    const float rstd = 1.f / sqrtf(wave_sum(s2) * (1.f / DM) + LN_EPS);
#pragma unroll
    for (int j = 0; j < 8; ++j) {
        const f32x4 gg = ((const f32x4*)g)[lane + 64 * j], bb = ((const f32x4*)b)[lane + 64 * j];
        const f32x4 o = v[j] * rstd * gg + bb;
        if (OUT_BF16) { u32x2 w; w.x = pk2(o[0], o[1]); w.y = pk2(o[2], o[3]); ((u32x2*)dst)[lane + 64 * j] = w; }
        else ((f32x4*)dst)[lane + 64 * j] = o;
    }
}

__device__ __forceinline__ void tr_item(const float* W, int ldw, int src_col0, int k0, bf16* WT, int K, int dst_row0, LAS float* scr, int lane) {
#pragma unroll 8
    for (int i = 0; i < 32; ++i) { const int kk = 2 * i + (lane >> 5); scr[kk * 33 + (lane & 31)] = W[(size_t)(k0 + kk) * ldw + src_col0 + (lane & 31)]; }
    LDS_WAIT(); asm volatile("" ::: "memory");
    const int c = lane & 7;
#pragma unroll
    for (int j = 0; j < 4; ++j) { const int n = (lane >> 3) + 8 * j; const LAS float* s = scr + (8 * c) * 33 + n;
        u32x4 o; o.x = pk2(s[0 * 33], s[1 * 33]); o.y = pk2(s[2 * 33], s[3 * 33]); o.z = pk2(s[4 * 33], s[5 * 33]); o.w = pk2(s[6 * 33], s[7 * 33]);
        *(u32x4*)(WT + (size_t)(dst_row0 + n) * K + k0 + 8 * c) = o; }
    LDS_WAIT(); asm volatile("" ::: "memory");
}

constexpr int VPITCH = 136;
constexpr int VS_OFF = 0, VM_OFF = 15 * 64 * VPITCH, RPB_OFF = VM_OFF + 16 * VPITCH, MB_OFF = RPB_OFF + 1920;
static_assert(MB_OFF + 64 <= LDS_BYTES, "attention LDS");
__device__ __forceinline__ bf16x8 ldv8(const LAS unsigned char* p, int o0, int o1, int o2, int o3, int o4, int o5, int o6, int o7) {
    bf16x8 a;
    a[0] = *(const LAS short*)(p + o0); a[1] = *(const LAS short*)(p + o1); a[2] = *(const LAS short*)(p + o2); a[3] = *(const LAS short*)(p + o3);
    a[4] = *(const LAS short*)(p + o4); a[5] = *(const LAS short*)(p + o5); a[6] = *(const LAS short*)(p + o6); a[7] = *(const LAS short*)(p + o7);
    return a;
}
__device__ __forceinline__ void attn_wave_item(LAS unsigned char* lds, const bf16* PROJ, bf16* MIX, int seqbase, int h, int r, int rs, int rsA, int qb, bool is_meta, int lane) {
    const int i = lane & 15, kq = lane >> 4;
    int c_lane, cb, qrow;
    if (is_meta) { c_lane = 0; cb = 0; qrow = seqbase + i; }
    else { c_lane = 16 * qb + i; cb = qb == 0 ? 0 : qb == 1 ? 8 : qb == 2 ? 24 : 32; qrow = seqbase + 16 + r * 64 + 16 * qb + i; }
    const int cs = min(max(c_lane - 8, 0), 48);
    const bf16* qp = PROJ + (size_t)qrow * NIN + 1024 + h * 64 + 8 * kq;
    const bf16x8 q0 = *(const bf16x8*)qp, q1 = *(const bf16x8*)(qp + 32);
    f32x4 S[17];
    const bf16* kbase = PROJ + (size_t)(seqbase + 16 + rs * 64 + cb + i) * NIN + 2048 + h * 64 + 8 * kq;
#pragma unroll
    for (int blk = 0; blk < 16; ++blk) { const int kr = blk >> 1, half = blk & 1;
        const bf16* kp = kbase + (size_t)(kr * 64 + 16 * half) * NIN;
        const bf16x8 k0 = *(const bf16x8*)kp, k1 = *(const bf16x8*)(kp + 32);
        f32x4 z = {0.f, 0.f, 0.f, 0.f};
        z = __builtin_amdgcn_mfma_f32_16x16x32_bf16(k0, q0, z, 0, 0, 0);
        S[blk] = __builtin_amdgcn_mfma_f32_16x16x32_bf16(k1, q1, z, 0, 0, 0); }
    { const bf16* kp = PROJ + (size_t)(seqbase + i) * NIN + 2048 + h * 64 + 8 * kq;
        const bf16x8 k0 = *(const bf16x8*)kp, k1 = *(const bf16x8*)(kp + 32);
        f32x4 z = {0.f, 0.f, 0.f, 0.f};
        z = __builtin_amdgcn_mfma_f32_16x16x32_bf16(k0, q0, z, 0, 0, 0);
        S[16] = __builtin_amdgcn_mfma_f32_16x16x32_bf16(k1, q1, z, 0, 0, 0); }
    const LAS float* rpbL = (const LAS float*)(lds + RPB_OFF); const LAS float* mbL = (const LAS float*)(lds + MB_OFF);
    float mx = -1e30f;
#pragma unroll
    for (int blk = 0; blk < 16; ++blk) { const int kr = blk >> 1, half = blk & 1; const int dr = rs + kr - r + 7;
#pragma unroll
        for (int jj = 0; jj < 4; ++jj) { const int kc = cb + 16 * half + 4 * kq + jj; const bool valid = (kc >= cs) && (kc < cs + 16);
            const int dc = min(max(kc - c_lane + 15, 0), 30);
            const float sc = S[blk][jj] * 0.125f + rpbL[dr * 31 + dc];
            S[blk][jj] = valid ? sc : -1e30f; mx = fmaxf(mx, S[blk][jj]); } }
#pragma unroll
    for (int jj = 0; jj < 4; ++jj) { S[16][jj] = S[16][jj] * 0.125f + mbL[4 * kq + jj]; mx = fmaxf(mx, S[16][jj]); }
    mx = fmaxf(mx, __shfl_xor(mx, 16)); mx = fmaxf(mx, __shfl_xor(mx, 32));
    float sum = 0.f;
#pragma unroll
    for (int blk = 0; blk < 17; ++blk)
#pragma unroll
        for (int jj = 0; jj < 4; ++jj) { const float p = __expf(S[blk][jj] - mx); S[blk][jj] = p; sum += p; }
    sum += __shfl_xor(sum, 16); sum += __shfl_xor(sum, 32);
    const float inv = 1.f / sum;
    f32x4 O[4];
#pragma unroll
    for (int d0 = 0; d0 < 4; ++d0) O[d0] = (f32x4){0.f, 0.f, 0.f, 0.f};
    const LAS unsigned char* vb = lds + VS_OFF + ((rs - rsA) * 64 + cb + 4 * kq) * VPITCH + i * 2;
#pragma unroll
    for (int kr = 0; kr < 8; ++kr) {
        const f32x4 pa = S[2 * kr] * inv, pb = S[2 * kr + 1] * inv;
        u32x4 pw; pw.x = pk2(pa[0], pa[1]); pw.y = pk2(pa[2], pa[3]); pw.z = pk2(pb[0], pb[1]); pw.w = pk2(pb[2], pb[3]);
        const bf16x8 B = __builtin_bit_cast(bf16x8, pw);
        const LAS unsigned char* vr = vb + kr * 64 * VPITCH;
#pragma unroll
        for (int d0 = 0; d0 < 4; ++d0) {
            const bf16x8 A = ldv8(vr + d0 * 32, 0, VPITCH, 2 * VPITCH, 3 * VPITCH, 16 * VPITCH, 17 * VPITCH, 18 * VPITCH, 19 * VPITCH);
            O[d0] = __builtin_amdgcn_mfma_f32_16x16x32_bf16(A, B, O[d0], 0, 0, 0); }
    }
    { const f32x4 pa = S[16] * inv; u32x4 pw; pw.x = pk2(pa[0], pa[1]); pw.y = pk2(pa[2], pa[3]); pw.z = 0u; pw.w = 0u;
        const bf16x8 B = __builtin_bit_cast(bf16x8, pw);
        const LAS unsigned char* vr = lds + VM_OFF + (4 * kq) * VPITCH + i * 2;
#pragma unroll
        for (int d0 = 0; d0 < 4; ++d0) {
            bf16x8 A = ldv8(vr + d0 * 32, 0, VPITCH, 2 * VPITCH, 3 * VPITCH, 0, VPITCH, 2 * VPITCH, 3 * VPITCH);
            O[d0] = __builtin_amdgcn_mfma_f32_16x16x32_bf16(A, B, O[d0], 0, 0, 0); }
    }
    bf16* op = MIX + (size_t)qrow * DM + 1024 + h * 64 + 4 * kq;
#pragma unroll
    for (int d0 = 0; d0 < 4; ++d0) { u32x2 w; w.x = pk2(O[d0][0], O[d0][1]); w.y = pk2(O[d0][2], O[d0][3]); *(u32x2*)(op + 16 * d0) = w; }
}

__global__ void __launch_bounds__(512) fwd_mega(Args a) {
    extern __shared__ __attribute__((aligned(16))) unsigned char lds_raw[];
    LAS unsigned char* lds = (LAS unsigned char*)lds_raw;
    cg::grid_group grid = cg::this_grid();
    const int tid = threadIdx.x, lane = tid & 63, wave = __builtin_amdgcn_readfirstlane(tid >> 6);
    const int G = gridDim.x, bx = blockIdx.x;
    unsigned char* ws = a.ws;
    bf16* WinT = (bf16*)(ws + WS_WIN); bf16* WoutT = (bf16*)(ws + WS_WOUT); bf16* WupT = (bf16*)(ws + WS_WUP); bf16* WdnT = (bf16*)(ws + WS_WDN);
    float* SIDE = (float*)(ws + WS_SIDE);
    bf16* H1 = (bf16*)(ws + WS_H1); bf16* MIX = H1; bf16* H0 = (bf16*)(ws + WS_H0); bf16* PROJ = (bf16*)(ws + WS_PROJ); bf16* ACT = (bf16*)(ws + WS_ACT);

    {
        LAS float* At = (LAS float*)lds;
        for (int it = bx; it < 256; it += G) {
            const int g = it >> 6, k0 = (it & 63) * 32;
            for (int idx = tid; idx < 32 * 64; idx += 512) { const int row = idx >> 6, c4 = idx & 63;
                *(LAS f32x4*)(At + row * 256 + c4 * 4) = *(const f32x4*)(a.w_in + (size_t)(k0 + row) * NIN + g * 256 + c4 * 4); }
            __syncthreads();
            const int e = tid & 255, kh = tid >> 8;
            float acc[16];
#pragma unroll
            for (int kk = 0; kk < 16; ++kk) acc[kk] = 0.f;
            const float* wp = a.w_pool + (size_t)g * 65536 + e;
            for (int c = 0; c < 256; c += 4) {
                const float p0 = wp[(c + 0) * 256], p1 = wp[(c + 1) * 256], p2 = wp[(c + 2) * 256], p3 = wp[(c + 3) * 256];
#pragma unroll
                for (int kk = 0; kk < 16; ++kk) { const f32x4 av = *(const LAS f32x4*)(At + (kh * 16 + kk) * 256 + c);
                    acc[kk] += (av[0] * p0 + av[1] * p1) + (av[2] * p2 + av[3] * p3); }
            }
            u32x4 o0, o1;
            o0.x = pk2(acc[0], acc[1]); o0.y = pk2(acc[2], acc[3]); o0.z = pk2(acc[4], acc[5]); o0.w = pk2(acc[6], acc[7]);
            o1.x = pk2(acc[8], acc[9]); o1.y = pk2(acc[10], acc[11]); o1.z = pk2(acc[12], acc[13]); o1.w = pk2(acc[14], acc[15]);
            bf16* dst = WinT + (size_t)(g * 256 + e) * DM + k0 + kh * 16;
            *(u32x4*)dst = o0; *(u32x4*)(dst + 8) = o1;
            __syncthreads();
        }
        LAS float* scr = (LAS float*)(lds + wave * 8448);
        const int gw = bx * 8 + wave, NGW = G * 8;
        constexpr int I_IN = 32 * 96, I_OUT = 32 * 64, I_UP = 32 * 344, I_DN = 86 * 64;
        for (int it = gw; it < I_IN + I_OUT + I_UP + I_DN; it += NGW) {
            int r = it;
            if (r < I_IN) { const int kb = r / 96, nb = r % 96; tr_item(a.w_in, NIN, 1024 + 32 * nb, 64 * kb, WinT, DM, 1024 + 32 * nb, scr, lane); continue; } r -= I_IN;
            if (r < I_OUT) { const int kb = r / 64, nb = r % 64; tr_item(a.w_out, DM, 32 * nb, 64 * kb, WoutT, DM, 32 * nb, scr, lane); continue; } r -= I_OUT;
            if (r < I_UP) { const int kb = r / 344, nb = r % 344; const int d0 = 32 * nb, j = d0 >> 8, idx = d0 & 255;
                const int sc0 = idx < 128 ? 128 * j + idx : DFF + 128 * j + idx - 128;
                tr_item(a.w_up, NUP, sc0, 64 * kb, WupT, DM, d0, scr, lane); continue; } r -= I_UP;
            { const int kb = r / 64, nb = r % 64; tr_item(a.w_down, DM, 32 * nb, 64 * kb, WdnT, DFF, 32 * nb, scr, lane); }
        }
        for (int R = gw; R < R_TOT; R += NGW) {
            const int s = seq_of_row(R), t = R - seq_start(s);
            const float* src;
            if (t < 16) src = a.meta_tokens + (size_t)t * DM;
            else { const int gr = grid_start(s) + t - 16; src = gr < 8192 ? a.x_prompt + (size_t)gr * DM : a.x_sample + (size_t)(gr - 8192) * DM; }
            ln_row<true>(src, a.ln_in_g, a.ln_in_b, H0 + (size_t)R * DM, lane);
        }
    }
    grid.sync();

    {
        pg8::Gemm g{H0, WinT, 0, 0, DM}; pg8::StaticOrder S; S.init(97 * 256, NIN, G, bx);
        pg8::EpiBf16 E{PROJ, NIN};
        pg8::gemm_phase<pg8::EpiBf16, pg8::RMNat, pg8::StaticOrder, true, true>(lds, g, S, E);
    }
    grid.sync();

    {
        for (int item = bx; item < 768; item += G) {
            const int cc = item >> 4, h = item & 15;
            const int s = cc < 8 ? 0 : cc < 16 ? 1 : cc < 32 ? 2 : 3;
            const int cidx = cc < 8 ? cc : cc < 16 ? cc - 8 : cc < 32 ? cc - 16 : cc - 32;
            const int rows = s < 2 ? 64 : 128, seqbase = seq_start(s);
            const int r0 = 8 * cidx;
            const int rsA = min(max(r0 - 4, 0), rows - 8), rsB = min(max(r0 + 3, 0), rows - 8), nrows = rsB + 8 - rsA;
            for (int itr = 0; itr < nrows; ++itr) { const int idx = tid + 512 * itr, key = idx >> 3, part = idx & 7;
                const u32x4 v = *(const u32x4*)(PROJ + (size_t)(seqbase + 16 + rsA * 64 + key) * NIN + 3072 + h * 64 + part * 8);
                LAS unsigned char* d = lds + VS_OFF + key * VPITCH + part * 16;
                *(LAS u32x2*)d = (u32x2){v.x, v.y}; *(LAS u32x2*)(d + 8) = (u32x2){v.z, v.w}; }
            if (tid < 128) { const int key = tid >> 3, part = tid & 7;
                const u32x4 v = *(const u32x4*)(PROJ + (size_t)(seqbase + key) * NIN + 3072 + h * 64 + part * 8);
                LAS unsigned char* d = lds + VM_OFF + key * VPITCH + part * 16;
                *(LAS u32x2*)d = (u32x2){v.x, v.y}; *(LAS u32x2*)(d + 8) = (u32x2){v.z, v.w}; }
            for (int idx = tid; idx < 465; idx += 512) ((LAS float*)(lds + RPB_OFF))[idx] = a.rpb[h * 465 + idx];
            if (tid < 16) ((LAS float*)(lds + MB_OFF))[tid] = a.meta_bias[h * 16 + tid];
            __syncthreads();
            const int nwi = 32 + (cidx == 0 ? 1 : 0);
            for (int wi = wave; wi < nwi; wi += 8) {
                if (wi < 32) { const int r = r0 + (wi >> 2), rs = min(max(r - 4, 0), rows - 8);
                    attn_wave_item(lds, PROJ, MIX, seqbase, h, r, rs, rsA, wi & 3, false, lane); }
                else attn_wave_item(lds, PROJ, MIX, seqbase, h, 0, 0, rsA, 0, true, lane);
            }
            __syncthreads();
        }
        for (int it = bx; it < R_TOT / 4; it += G) {
            const int R = it * 4 + (tid >> 7), vec = tid & 127;
            const int s = seq_of_row(R), st = seq_start(s), t = R - st, L = seq_len(s);
            const int g = vec >> 5, w = 2 << g;
            const int lo = max(t - (w >> 1), 0), hi = min(t + (w >> 1), L);
            float sum[8];
#pragma unroll
            for (int j = 0; j < 8; ++j) sum[j] = 0.f;
            for (int tt = lo; tt < hi; ++tt) { const u32x4 v = *(const u32x4*)(PROJ + (size_t)(st + tt) * NIN + vec * 8);
                sum[0] += __uint_as_float(v.x << 16); sum[1] += __uint_as_float(v.x & 0xffff0000u); sum[2] += __uint_as_float(v.y << 16); sum[3] += __uint_as_float(v.y & 0xffff0000u);
                sum[4] += __uint_as_float(v.z << 16); sum[5] += __uint_as_float(v.z & 0xffff0000u); sum[6] += __uint_as_float(v.w << 16); sum[7] += __uint_as_float(v.w & 0xffff0000u); }
            const u32x4 uv = *(const u32x4*)(PROJ + (size_t)R * NIN + vec * 8);
            const float ic = 1.f / (float)(hi - lo);
            const f32x4 ps0 = *(const f32x4*)(a.pool_scale + vec * 8), ps1 = *(const f32x4*)(a.pool_scale + vec * 8 + 4);
            float o[8];
            o[0] = (sum[0] * ic - __uint_as_float(uv.x << 16)) * ps0[0]; o[1] = (sum[1] * ic - __uint_as_float(uv.x & 0xffff0000u)) * ps0[1];
            o[2] = (sum[2] * ic - __uint_as_float(uv.y << 16)) * ps0[2]; o[3] = (sum[3] * ic - __uint_as_float(uv.y & 0xffff0000u)) * ps0[3];
            o[4] = (sum[4] * ic - __uint_as_float(uv.z << 16)) * ps1[0]; o[5] = (sum[5] * ic - __uint_as_float(uv.z & 0xffff0000u)) * ps1[1];
            o[6] = (sum[6] * ic - __uint_as_float(uv.w << 16)) * ps1[2]; o[7] = (sum[7] * ic - __uint_as_float(uv.w & 0xffff0000u)) * ps1[3];
            u32x4 ov; ov.x = pk2(o[0], o[1]); ov.y = pk2(o[2], o[3]); ov.z = pk2(o[4], o[5]); ov.w = pk2(o[6], o[7]);
            *(u32x4*)(MIX + (size_t)R * DM + vec * 8) = ov;
        }
    }
    grid.sync();

    {
        pg8::Gemm g{MIX, WoutT, 0, 0, DM}; pg8::StaticOrder S; S.init(97 * 256, DM, G, bx);
        pg8::EpiRes<0> E{H0, a.out, SIDE};
        pg8::gemm_phase<pg8::EpiRes<0>, pg8::RMNat, pg8::StaticOrder, true, true>(lds, g, S, E);
    }
    grid.sync();
    {
        const int gw = bx * 8 + wave, NGW = G * 8;
        for (int R = gw; R < R_TOT; R += NGW) {
            const int s = seq_of_row(R), t = R - seq_start(s);
            const float* src = (t < 16) ? SIDE + (size_t)(s * 16 + t) * DM : a.out + (size_t)(grid_start(s) + t - 16) * DM;
            ln_row<true>(src, a.ln1_g, a.ln1_b, H1 + (size_t)R * DM, lane);
        }
    }
    grid.sync();
    {
        pg8::Gemm g{H1, WupT, 0, 0, DM}; pg8::StaticOrder S; S.init(98 * 256, NUP, G, bx);
        pg8::EpiConvGate E{ACT, a.b_up, a.conv_w, a.conv_b, (LAS float*)(lds + XCH_OFF)};
        pg8::gemm_phase<pg8::EpiConvGate, pg8::RMUp, pg8::StaticOrder, true, true>(lds, g, S, E);
    }
    grid.sync();
    {
        pg8::Gemm g{ACT, WdnT, 0, 0, DFF}; pg8::StaticOrder S; S.init(96 * 256, DM, G, bx);
        pg8::EpiRes<1> E{H1, a.out, SIDE};
        pg8::gemm_phase<pg8::EpiRes<1>, pg8::RMGrid, pg8::StaticOrder, true, true>(lds, g, S, E);
    }
    grid.sync();
    {
        const int gw = bx * 8 + wave, NGW = G * 8;
        for (int R = gw; R < G_TOT; R += NGW) ln_row<false>(a.out + (size_t)R * DM, a.ln2_g, a.ln2_b, a.out + (size_t)R * DM, lane);
    }
}

extern "C" void kernel_launch(void* const* d_in, const int* in_sizes, int n_in, void* d_out, int out_size, void* d_ws, size_t ws_size, hipStream_t stream) {
    static int grid = 0;
    if (grid == 0) {
        int dev = 0, cus = 0, per = 0;
        if (n_in != 20 || out_size != G_TOT * DM || ws_size < WS_END) { fprintf(stderr, "kernel_launch: unexpected shapes (n_in %d out %d ws %zu)\n", n_in, out_size, ws_size); grid = -1; return; }
        (void)hipGetDevice(&dev); (void)hipDeviceGetAttribute(&cus, hipDeviceAttributeMultiprocessorCount, dev);
        (void)hipFuncSetAttribute((const void*)fwd_mega, hipFuncAttributeMaxDynamicSharedMemorySize, LDS_BYTES);
        (void)hipOccupancyMaxActiveBlocksPerMultiprocessor(&per, (const void*)fwd_mega, 512, LDS_BYTES);
        if (per < 1) per = 1;
        grid = cus * per;
        (void)hipGetLastError();
    }
    if (grid < 0) return;
    Args a{};
    const float** p = (const float**)&a;
    for (int i = 0; i < 20; ++i) p[i] = (const float*)d_in[i];
    a.out = (float*)d_out; a.ws = (unsigned char*)d_ws;
    void* args[] = {&a};
    hipError_t e = hipLaunchCooperativeKernel((const void*)fwd_mega, dim3(grid), dim3(512), args, LDS_BYTES, stream);
    if (e != hipSuccess) fprintf(stderr, "cooperative launch failed: %s (grid %d)\n", hipGetErrorString(e), grid);
}
```

```cpp
#define REPS 1,1,1,1,1,1,1,1
#include <hip/hip_runtime.h>
#include <hip/hip_cooperative_groups.h>
#include <cstdio>
#include <cstdint>
namespace cg = cooperative_groups;

constexpr int DM = 2048, NIN = 4096, DFF = 5504, NUP = 2 * DFF;
constexpr int R_TOT = 24640;
constexpr int G_TOT = 24576;
constexpr float LN_EPS = 1e-5f;
constexpr float ALPHA = 1.189207115002721f;
__device__ __forceinline__ int seq_of_row(int R) { return (R >= 4112) + (R >= 8224) + (R >= 16432); }
__device__ __forceinline__ int seq_start(int s) { return s == 0 ? 0 : s == 1 ? 4112 : s == 2 ? 8224 : 16432; }
__device__ __forceinline__ int seq_len(int s) { return s < 2 ? 4112 : 8208; }
__device__ __forceinline__ int grid_start(int s) { return s == 0 ? 0 : s == 1 ? 4096 : s == 2 ? 8192 : 16384; }

constexpr size_t MiB = 1u << 20;
constexpr size_t WS_WIN = 0, WS_WOUT = 16 * MiB, WS_WUP = 24 * MiB, WS_WDN = 67 * MiB, WS_SIDE = 89 * MiB;
constexpr size_t WS_H1 = 90 * MiB + 4096;
constexpr size_t WS_H0 = 189 * MiB, WS_PROJ = 287 * MiB, WS_ACT = 189 * MiB, WS_END = 481 * MiB;

constexpr int LDS_BYTES = 147456;
constexpr int XCH_OFF = 131072;
namespace pg8 {
#define PG8_LAS __attribute__((address_space(3)))
typedef unsigned short bf16_t;
typedef short bf16x8 __attribute__((ext_vector_type(8)));
typedef float f32x4 __attribute__((ext_vector_type(4)));
typedef unsigned u32x4 __attribute__((ext_vector_type(4)));
constexpr int BM = 256, BK = 64, HALF = 128, HTB = HALF * BK * 2  , STAGE_BYTES = 8 * HTB, NXCD = 8, WGM = 8;

__host__ __device__ __forceinline__ int lds_byte(int r, int c) { const int st = (r >> 4) * 2 + (c >> 5), rr = r & 15, cc = c & 31, ob = rr * 64 + cc * 2; return st * 1024 + (ob ^ (((ob >> 9) & 1) << 5)); }
__host__ __device__ __forceinline__ void stage_rc(int b, int& R, int& C) { const int st = b / 1024, sb = b % 1024, swz = sb ^ (((sb >> 9) & 1) << 5); R = (st >> 1) * 16 + swz / 64; C = (st & 1) * 32 + (swz % 64) / 2; }
__host__ __device__ __forceinline__ int perm32(int rho) { const int n = rho >> 4, i = rho & 15; return 8 * (i >> 2) + 4 * n + (i & 3); }

struct Unit { int pm, pn; };
struct Gemm { const bf16_t* A; const bf16_t* Bt; int M, N, K; };

struct StaticOrder {
    int nM, nN, nwg, G, c;
    __host__ __device__ void init(int M, int N, int G_, int c_) { nM = M / BM; nN = N / BM; nwg = nM * nN; G = G_; c = c_; }
    __host__ __device__ bool next(int i, Unit& u) const {
        const long L = (long)i * G + c; if (L >= nwg) return false;
        int wgid = (int)L; { const int q = nwg / NXCD, r = nwg % NXCD, xcd = wgid % NXCD, off = wgid / NXCD; wgid = (xcd < r ? xcd * (q + 1) : r * (q + 1) + (xcd - r) * q) + off; }
        const int nig = WGM * nN, gid = wgid / nig, fm = gid * WGM, gsz = (nM - fm) < WGM ? (nM - fm) : WGM;
        u.pm = fm + ((wgid % nig) % gsz); u.pn = (wgid % nig) / gsz; return true;
    }
    __device__ __forceinline__ void a_ready(const Unit&) const {}
    __device__ __forceinline__ void done(const Unit&) const {}
};

__device__ __forceinline__ unsigned cvt_pk_bf16(float lo, float hi) { unsigned r; asm volatile("v_cvt_pk_bf16_f32 %0, %1, %2" : "=v"(r) : "v"(lo), "v"(hi)); return r; }
typedef float f32x2 __attribute__((ext_vector_type(2)));
__device__ __forceinline__ f32x2 gelu_pk(f32x2 v) {
    const f32x2 av = __builtin_elementwise_abs(v), d = av * 0.2316418882f + 1.0f;
    f32x2 t; t.x = __builtin_amdgcn_rcpf(d.x); t.y = __builtin_amdgcn_rcpf(d.y);
    f32x2 q = t * 0.5307027145f + (-0.7265760135f); q = q * t + 0.7107068705f; q = q * t + (-0.142248368f); q = q * t + 0.127414796f; q = q * t;
    const f32x2 s = (v * v) * (-0.72134752044f);
    f32x2 e; e.x = __builtin_amdgcn_exp2f(s.x); e.y = __builtin_amdgcn_exp2f(s.y);
    const f32x2 m = v * (q * e), r = v - m;
    f32x2 o; o.x = v.x < 0.f ? m.x : r.x; o.y = v.y < 0.f ? m.y : r.y; return o;
}

struct RMNat  { static __device__ __forceinline__ int arow(int pm) { return pm * 256; } };
struct RMUp   { static __device__ __forceinline__ int arow(int pm) { return pm * 254 - 1; } };
struct RMGrid { static __device__ __forceinline__ int arow(int pm) { return pm * 256 + 16 * (1 + (pm >= 16) + (pm >= 32) + (pm >= 64)); } };

__device__ __forceinline__ float bf2f(unsigned short b) { return __uint_as_float((unsigned)b << 16); }

template <class RM> struct EpiBf16 {
    static constexpr bool PERM = true, AFTER_DRAIN = false;
    bf16_t* O; int ldc;
    __device__ __forceinline__ void operator()(const f32x4 (&acc)[2][2][4][2], const Unit& u, int wr, int wc, int fr, int fq) const {
        const int row0 = RM::arow(u.pm) + wr * 64 + fr; const int col0 = u.pn * BM + wc * 32 + 8 * fq;
#pragma unroll
        for (int ai = 0; ai < 2; ++ai)
#pragma unroll
            for (int m = 0; m < 4; ++m) { bf16_t* rowp = O + (size_t)(row0 + ai * HALF + m * 16) * ldc + col0;
#pragma unroll
                for (int bj = 0; bj < 2; ++bj) { const f32x4 v0 = acc[ai][bj][m][0], v1 = acc[ai][bj][m][1];
                    u32x4 w; w.x = cvt_pk_bf16(v0[0], v0[1]); w.y = cvt_pk_bf16(v0[2], v0[3]); w.z = cvt_pk_bf16(v1[0], v1[1]); w.w = cvt_pk_bf16(v1[2], v1[3]);
                    *(u32x4*)(rowp + bj * HALF) = w; } }
    }
};

template <int MODE> struct EpiRes {
    static constexpr bool PERM = true, AFTER_DRAIN = false;
    const bf16_t* Hres; float* out; float* side;
    __device__ __forceinline__ void operator()(const f32x4 (&acc)[2][2][4][2], const Unit& u, int wr, int wc, int fr, int fq) const {
        const int col0 = u.pn * BM + wc * 32 + 8 * fq;
#pragma unroll
        for (int ai = 0; ai < 2; ++ai)
#pragma unroll
            for (int m = 0; m < 4; ++m) {
                const int r = ai * HALF + wr * 64 + m * 16 + fr;
                float* dst; const bf16_t* res; bool ok = true;
                if (MODE == 0) { const int R = u.pm * BM + r; ok = R < R_TOT; const int s = seq_of_row(R), t = R - seq_start(s);
                    dst = (t < 16) ? side + (size_t)(s * 16 + t) * DM : out + (size_t)(grid_start(s) + t - 16) * DM; res = Hres + (size_t)R * DM; }
                else { dst = out + (size_t)(u.pm * BM + r) * DM; res = Hres + (size_t)(RMGrid::arow(u.pm) + r) * DM; }
                if (ok) {
#pragma unroll
                    for (int bj = 0; bj < 2; ++bj) {
                        const u32x4 hv = *(const u32x4*)(res + col0 + bj * HALF);
                        f32x4 h0, h1;
                        h0[0] = __uint_as_float(hv.x << 16); h0[1] = __uint_as_float(hv.x & 0xffff0000u); h0[2] = __uint_as_float(hv.y << 16); h0[3] = __uint_as_float(hv.y & 0xffff0000u);
                        h1[0] = __uint_as_float(hv.z << 16); h1[1] = __uint_as_float(hv.z & 0xffff0000u); h1[2] = __uint_as_float(hv.w << 16); h1[3] = __uint_as_float(hv.w & 0xffff0000u);
                        *(f32x4*)(dst + col0 + bj * HALF) = acc[ai][bj][m][0] + h0 * ALPHA;
                        *(f32x4*)(dst + col0 + bj * HALF + 4) = acc[ai][bj][m][1] + h1 * ALPHA; } }
            }
    }
};

__device__ __forceinline__ float dppf(float old, float src, const int ctrl_sel) {
    const int o = __float_as_int(old), s = __float_as_int(src); int r;
    if (ctrl_sel == 0) r = __builtin_amdgcn_update_dpp(o, s, 0x111, 0xf, 0xf, false);
    else if (ctrl_sel == 1) r = __builtin_amdgcn_update_dpp(o, s, 0x101, 0xf, 0xf, false);
    else if (ctrl_sel == 2) r = __builtin_amdgcn_update_dpp(o, s, 0x121, 0xf, 0xf, false);
    else r = __builtin_amdgcn_update_dpp(o, s, 0x12f, 0xf, 0xf, false);
    return __int_as_float(r);
}
__device__ __forceinline__ f32x4 lds_rd128_pinned(const PG8_LAS float* p) { f32x4 v; asm volatile("ds_read_b128 %0, %1\n\ts_waitcnt lgkmcnt(0)" : "=v"(v) : "v"((unsigned)(uintptr_t)p) : "memory"); return v; }
struct EpiConvGate {
    static constexpr bool PERM = true, AFTER_DRAIN = false;
    bf16_t* ACT; const float* b_up; const float* conv_w; const float* conv_b; PG8_LAS float* X;
    __device__ __forceinline__ void operator()(f32x4 (&acc)[2][2][4][2], const Unit& u, int wr, int wc, int fr, int fq) const {
        const int lc0 = wc * 32 + 8 * fq, ca0 = u.pn * HALF + lc0;
#pragma unroll
        for (int bj = 0; bj < 2; ++bj)
#pragma unroll
            for (int n = 0; n < 2; ++n) { const f32x4 bv = *(const f32x4*)(b_up + bj * DFF + ca0 + 4 * n);
#pragma unroll
                for (int ai = 0; ai < 2; ++ai)
#pragma unroll
                    for (int m = 0; m < 4; ++m) acc[ai][bj][m][n] += bv; }
        if (fr == 0) {
#pragma unroll
            for (int ai = 0; ai < 2; ++ai)
#pragma unroll
                for (int bj = 0; bj < 2; ++bj)
#pragma unroll
                    for (int n = 0; n < 2; ++n) *(PG8_LAS f32x4*)(X + (((ai * 2 + wr) * 2 + 0) * 256 + bj * HALF + lc0 + 4 * n)) = acc[ai][bj][0][n];
        }
        if (fr == 15) {
#pragma unroll
            for (int ai = 0; ai < 2; ++ai)
#pragma unroll
                for (int bj = 0; bj < 2; ++bj)
#pragma unroll
                    for (int n = 0; n < 2; ++n) *(PG8_LAS f32x4*)(X + (((ai * 2 + wr) * 2 + 1) * 256 + bj * HALF + lc0 + 4 * n)) = acc[ai][bj][3][n];
        }
        asm volatile("s_waitcnt lgkmcnt(0)" ::: "memory"); __builtin_amdgcn_s_barrier(); asm volatile("" ::: "memory");
        const int Rt = 254 * u.pm - 1;
#pragma unroll
        for (int n = 0; n < 2; ++n) {
            f32x4 w0[2], w1[2], w2[2], cbv[2];
#pragma unroll
            for (int bj = 0; bj < 2; ++bj) { const int ch = bj * DFF + ca0 + 4 * n;
                w0[bj] = *(const f32x4*)(conv_w + ch); w1[bj] = *(const f32x4*)(conv_w + NUP + ch); w2[bj] = *(const f32x4*)(conv_w + 2 * NUP + ch); cbv[bj] = *(const f32x4*)(conv_b + ch); }
#pragma unroll
            for (int ai = 0; ai < 2; ++ai)
#pragma unroll
                for (int m = 0; m < 4; ++m) {
                    const int r = ai * HALF + wr * 64 + m * 16 + fr, R = Rt + r;
                    const bool zp = (R == 0) | (R == 4112) | (R == 8224) | (R == 16432);
                    const bool zn = (R == 4111) | (R == 8223) | (R == 16431) | (R == 24639);
                    f32x4 z[2];
#pragma unroll
                    for (int bj = 0; bj < 2; ++bj) {
                        const f32x4 cur = acc[ai][bj][m][n]; f32x4 ep, en;
                        const int chk = ai * 2 + wr;
                        if (m > 0) { const f32x4 pb = acc[ai][bj][m > 0 ? m - 1 : 0][n];
#pragma unroll
                            for (int e = 0; e < 4; ++e) ep[e] = dppf(0.f, pb[e], 2); }
                        else { const int pc = chk > 0 ? chk - 1 : 0; ep = lds_rd128_pinned(X + ((pc * 2 + 1) * 256 + bj * HALF + lc0 + 4 * n)); }
                        if (m < 3) { const f32x4 nb = acc[ai][bj][m < 3 ? m + 1 : 3][n];
#pragma unroll
                            for (int e = 0; e < 4; ++e) en[e] = dppf(0.f, nb[e], 3); }
                        else { const int nc = chk < 3 ? chk + 1 : 3; en = lds_rd128_pinned(X + ((nc * 2 + 0) * 256 + bj * HALF + lc0 + 4 * n)); }
                        f32x4 pv, nv;
#pragma unroll
                        for (int e = 0; e < 4; ++e) { pv[e] = dppf(ep[e], cur[e], 0); nv[e] = dppf(en[e], cur[e], 1); pv[e] = zp ? 0.f : pv[e]; nv[e] = zn ? 0.f : nv[e]; }
                        z[bj] = w0[bj] * pv + w1[bj] * cur + w2[bj] * nv + cbv[bj];
                    }
                    const f32x2 g0 = gelu_pk((f32x2){z[1][0], z[1][1]}), g1 = gelu_pk((f32x2){z[1][2], z[1][3]});
                    unsigned o0 = cvt_pk_bf16(z[0][0] * g0.x, z[0][1] * g0.y), o1 = cvt_pk_bf16(z[0][2] * g1.x, z[0][3] * g1.y);
                    if (r >= 1 && r <= 254 && R < R_TOT) { typedef unsigned u32x2v __attribute__((ext_vector_type(2))); u32x2v w; w.x = o0; w.y = o1;
                        *(u32x2v*)(ACT + (size_t)R * DFF + ca0 + 4 * n) = w; }
                }
        }
    }
};

template <class Epi, class RM, class Sched, bool ALIGN_EPI = false, bool SP2 = false>
__device__ __forceinline__ void gemm_phase(PG8_LAS unsigned char* lds, const Gemm g, const Sched& S, const Epi& E) {
    int tid_ = threadIdx.x; asm volatile("" : "+v"(tid_));
    const int tid = tid_, wid = __builtin_amdgcn_readfirstlane(tid >> 6), lane = tid & 63, wr = wid >> 2, wc = wid & 3, fr = lane & 15, fq = lane >> 4;
    const int K = g.K, nt = K / BK;
    unsigned voffA[2], voffB[2];
#pragma unroll
    for (int i = 0; i < 2; ++i) { int R, C; stage_rc(tid * 16 + i * 8192, R, C); const int Rb = Epi::PERM ? ((R & ~31) + perm32(R & 31)) : R;
        voffA[i] = (unsigned)(R * K + C) * 2u; voffB[i] = (unsigned)(Rb * K + C) * 2u; }
    const size_t kstep = (size_t)(BK * 2);
    const size_t hstep = (size_t)HALF * K * 2;
    const size_t tstep = 2 * hstep; const ptrdiff_t rowb = (ptrdiff_t)K * 2;
    const unsigned ldsw = (unsigned)wid * 1024u;
    const int aoff = lds_byte(wr * 64 + fr, fq * 8), boff = lds_byte(wc * 32 + fr, fq * 8);
#define PG8_SA(b, h) (((b) * 2 + (h)) * HTB)
#define PG8_SB(b, h) ((4 + (b) * 2 + (h)) * HTB)
#define PG8_STAGE(bufoff, gbase, voff) do { _Pragma("unroll") for (int _i = 0; _i < 2; ++_i) \
        __builtin_amdgcn_global_load_lds((const unsigned*)((const char*)(gbase) + (voff)[_i]), (PG8_LAS unsigned*)(lds + (bufoff) + ldsw + _i * 8192), 16, 0, 0); } while (0)
#define PG8_LDA(dst, b, h) do { _Pragma("unroll") for (int m = 0; m < 4; ++m) _Pragma("unroll") for (int k = 0; k < 2; ++k) dst[m][k] = *(const PG8_LAS bf16x8*)(lds + PG8_SA(b, h) + aoff + m * 2048 + k * 1024); } while (0)
#define PG8_LDB(dst, b, h) do { _Pragma("unroll") for (int n = 0; n < 2; ++n) _Pragma("unroll") for (int k = 0; k < 2; ++k) dst[n][k] = *(const PG8_LAS bf16x8*)(lds + PG8_SB(b, h) + boff + n * 2048 + k * 1024); } while (0)
#define PG8_MMA(ai, bj, At, Bt) do { __builtin_amdgcn_s_setprio(1); _Pragma("unroll") for (int m = 0; m < 4; ++m) _Pragma("unroll") for (int n = 0; n < 2; ++n) _Pragma("unroll") for (int k = 0; k < 2; ++k) \
        acc[ai][bj][m][n] = __builtin_amdgcn_mfma_f32_16x16x32_bf16(Bt[n][k], At[m][k], acc[ai][bj][m][n], 0, 0, 0); __builtin_amdgcn_s_setprio(0); } while (0)
#define PG8_WAIT_V(n) asm volatile("s_waitcnt vmcnt(" #n ")" ::: "memory")
#define PG8_WAIT_L(n) asm volatile("s_waitcnt lgkmcnt(" #n ")" ::: "memory")
#define PG8_BAR __builtin_amdgcn_s_barrier()
#define PG8_SCHED __builtin_amdgcn_sched_barrier(0)
    Unit cur, nxt; int ui = 0;
    if (!S.next(0, cur)) return;
    f32x4 acc[2][2][4][2];
#pragma unroll
    for (int a = 0; a < 2; ++a)
#pragma unroll
        for (int b = 0; b < 2; ++b)
#pragma unroll
            for (int m = 0; m < 4; ++m)
#pragma unroll
                for (int n = 0; n < 2; ++n) acc[a][b][m][n] = (f32x4){0.f, 0.f, 0.f, 0.f};
    bf16x8 At[4][2], B0[2][2], B1[2][2];
    const char* cA = (const char*)g.A + (ptrdiff_t)RM::arow(cur.pm) * rowb; const char* cB = (const char*)g.Bt + (size_t)cur.pn * tstep;
    S.a_ready(cur);
    if constexpr (SP2) {
        PG8_STAGE(PG8_SB(0, 0), cB, voffB); PG8_STAGE(PG8_SB(0, 1), cB + hstep, voffB); PG8_STAGE(PG8_SA(0, 0), cA, voffA); PG8_STAGE(PG8_SA(0, 1), cA + hstep, voffA);
        if (wr == 1) PG8_BAR;
        PG8_WAIT_V(2); PG8_BAR;
        PG8_STAGE(PG8_SB(1, 0), cB + kstep, voffB); PG8_STAGE(PG8_SA(1, 0), cA + kstep, voffA); PG8_STAGE(PG8_SB(1, 1), cB + hstep + kstep, voffB);
        PG8_WAIT_V(6); PG8_BAR;
    } else {
        PG8_STAGE(PG8_SB(0, 0), cB, voffB); PG8_STAGE(PG8_SA(0, 0), cA, voffA); PG8_STAGE(PG8_SB(0, 1), cB + hstep, voffB); PG8_STAGE(PG8_SA(0, 1), cA + hstep, voffA);
        if (wr == 1) PG8_BAR;
        PG8_WAIT_V(4); PG8_BAR;
        PG8_STAGE(PG8_SB(1, 0), cB + kstep, voffB); PG8_STAGE(PG8_SA(1, 0), cA + kstep, voffA); PG8_STAGE(PG8_SB(1, 1), cB + hstep + kstep, voffB);
        PG8_WAIT_V(6); PG8_BAR;
    }
    for (;;) {
        const bool has_next = S.next(ui + 1, nxt);
        const char* nA = has_next ? (const char*)g.A + (ptrdiff_t)RM::arow(nxt.pm) * rowb : cA; const char* nB = has_next ? (const char*)g.Bt + (size_t)nxt.pn * tstep : cB;
        for (int t = 0; t < nt; t += 2) {
            const bool last = (t == nt - 2);
            const char* a1 = cA + (size_t)(t + 1) * kstep;
            const char* a2 = last ? nA : cA + (size_t)(t + 2) * kstep; const char* b2 = last ? nB : cB + (size_t)(t + 2) * kstep;
            const char* a3 = a2 + kstep; const char* b3 = b2 + kstep;
            if (last && has_next) S.a_ready(nxt);
            if constexpr (SP2) {
            PG8_LDB(B0, 0, 0); PG8_LDB(B1, 0, 1); PG8_SCHED; PG8_LDA(At, 0, 0); PG8_STAGE(PG8_SA(1, 1), a1 + hstep, voffA);
            PG8_WAIT_V(8); PG8_WAIT_L(0); PG8_BAR; PG8_MMA(0, 0, At, B0); PG8_MMA(0, 1, At, B1); PG8_BAR; PG8_SCHED;
            PG8_LDA(At, 0, 1); PG8_STAGE(PG8_SB(0, 0), b2, voffB); PG8_STAGE(PG8_SB(0, 1), b2 + hstep, voffB); PG8_STAGE(PG8_SA(0, 0), a2, voffA);
            PG8_WAIT_V(8); PG8_WAIT_L(0); PG8_BAR; PG8_MMA(1, 0, At, B0); PG8_MMA(1, 1, At, B1); PG8_BAR; PG8_SCHED;
            PG8_LDB(B0, 1, 0); PG8_LDB(B1, 1, 1); PG8_SCHED; PG8_LDA(At, 1, 0); PG8_STAGE(PG8_SA(0, 1), a2 + hstep, voffA);
            PG8_WAIT_V(8); PG8_WAIT_L(0); PG8_BAR; PG8_MMA(0, 0, At, B0); PG8_MMA(0, 1, At, B1); PG8_BAR; PG8_SCHED;
            PG8_LDA(At, 1, 1); PG8_STAGE(PG8_SB(1, 0), b3, voffB); PG8_STAGE(PG8_SB(1, 1), b3 + hstep, voffB); PG8_STAGE(PG8_SA(1, 0), a3, voffA);
            PG8_WAIT_V(8); PG8_WAIT_L(0); PG8_BAR; PG8_MMA(1, 0, At, B0); PG8_MMA(1, 1, At, B1); PG8_BAR; PG8_SCHED;
            } else {
            PG8_LDB(B0, 0, 0); PG8_SCHED; PG8_LDA(At, 0, 0); PG8_STAGE(PG8_SA(1, 1), a1 + hstep, voffA);
            PG8_WAIT_L(8); PG8_BAR; PG8_WAIT_L(0); PG8_MMA(0, 0, At, B0); PG8_BAR; PG8_SCHED;
            PG8_LDB(B1, 0, 1); PG8_STAGE(PG8_SB(0, 0), b2, voffB);
            PG8_BAR; PG8_WAIT_L(0); PG8_MMA(0, 1, At, B1); PG8_BAR;
            PG8_LDA(At, 0, 1); PG8_STAGE(PG8_SA(0, 0), a2, voffA);
            PG8_BAR; PG8_WAIT_L(0); PG8_MMA(1, 0, At, B0); PG8_BAR; PG8_SCHED;
            PG8_STAGE(PG8_SB(0, 1), b2 + hstep, voffB);
            PG8_WAIT_V(6); PG8_BAR; PG8_MMA(1, 1, At, B1); PG8_BAR;
            PG8_LDB(B0, 1, 0); PG8_SCHED; PG8_LDA(At, 1, 0); PG8_STAGE(PG8_SA(0, 1), a2 + hstep, voffA);
            PG8_WAIT_L(8); PG8_BAR; PG8_WAIT_L(0); PG8_MMA(0, 0, At, B0); PG8_BAR; PG8_SCHED;
            PG8_LDB(B1, 1, 1); PG8_STAGE(PG8_SB(1, 0), b3, voffB);
            PG8_BAR; PG8_WAIT_L(0); PG8_MMA(0, 1, At, B1); PG8_BAR;
            PG8_LDA(At, 1, 1); PG8_STAGE(PG8_SA(1, 0), a3, voffA);
            PG8_BAR; PG8_WAIT_L(0); PG8_MMA(1, 0, At, B0); PG8_BAR; PG8_SCHED;
            PG8_STAGE(PG8_SB(1, 1), b3 + hstep, voffB);
            PG8_WAIT_V(6); PG8_BAR; PG8_MMA(1, 1, At, B1); PG8_BAR;
            }
        }
        if constexpr (ALIGN_EPI) { if (wr == 0) PG8_BAR; }
        if constexpr (!Epi::AFTER_DRAIN) { E(acc, cur, wr, wc, fr, fq); S.done(cur); }
        if (!has_next) break;
#pragma unroll
        for (int a = 0; a < 2; ++a)
#pragma unroll
            for (int b = 0; b < 2; ++b)
#pragma unroll
                for (int m = 0; m < 4; ++m)
#pragma unroll
                    for (int n = 0; n < 2; ++n) acc[a][b][m][n] = (f32x4){0.f, 0.f, 0.f, 0.f};
        cur = nxt; cA = nA; cB = nB; ++ui;
        if constexpr (ALIGN_EPI) { if (wr == 1) PG8_BAR; }
    }
    PG8_WAIT_V(0);
    if constexpr (!ALIGN_EPI) { if (wr == 0) PG8_BAR; }
    PG8_BAR;
    if constexpr (Epi::AFTER_DRAIN) { E.fused(acc, cur, wr, wc, fr, fq, lds, wid, lane); S.done(cur); }
#undef PG8_SA
#undef PG8_SB
#undef PG8_STAGE
#undef PG8_LDA
#undef PG8_LDB
#undef PG8_MMA
#undef PG8_WAIT_V
#undef PG8_WAIT_L
#undef PG8_BAR
#undef PG8_SCHED
}
}
#define LAS __attribute__((address_space(3)))
typedef unsigned short bf16;
typedef float f32x4 __attribute__((ext_vector_type(4)));
typedef short bf16x8 __attribute__((ext_vector_type(8)));
typedef unsigned u32x4 __attribute__((ext_vector_type(4)));
typedef unsigned u32x2 __attribute__((ext_vector_type(2)));
#define LDS_WAIT() asm volatile("s_waitcnt lgkmcnt(0)" ::: "memory")
__device__ __forceinline__ unsigned pk2(float lo, float hi) { return pg8::cvt_pk_bf16(lo, hi); }

struct Args {
    const float *x_prompt, *x_sample, *meta_tokens, *ln_in_g, *ln_in_b, *w_in, *w_pool, *pool_scale, *rpb, *meta_bias, *w_out, *ln1_g, *ln1_b,
                *w_up, *b_up, *conv_w, *conv_b, *w_down, *ln2_g, *ln2_b;
    float* out; unsigned char* ws;
};

__device__ __forceinline__ float wave_sum(float v) {
#pragma unroll
    for (int o = 1; o < 64; o <<= 1) v += __shfl_xor(v, o);
    return v;
}
template <bool OUT_BF16> __device__ __forceinline__ void ln_row(const float* src, const float* g, const float* b, void* dst, int lane) {
    const f32x4* xr = (const f32x4*)src + lane;
    f32x4 v[8]; float s = 0.f;
#pragma unroll
    for (int j = 0; j < 8; ++j) { v[j] = xr[64 * j]; s += (v[j][0] + v[j][1]) + (v[j][2] + v[j][3]); }
    const float mean = wave_sum(s) * (1.f / DM); float s2 = 0.f;
#pragma unroll
    for (int j = 0; j < 8; ++j) { v[j] = v[j] - mean; s2 += (v[j][0] * v[j][0] + v[j][1] * v[j][1]) + (v[j][2] * v[j][2] + v[j][3] * v[j][3]); }
    const float rstd = 1.f / sqrtf(wave_sum(s2) * (1.f / DM) + LN_EPS);
#pragma unroll
    for (int j = 0; j < 8; ++j) {
        const f32x4 gg = ((const f32x4*)g)[lane + 64 * j], bb = ((const f32x4*)b)[lane + 64 * j];
        const f32x4 o = v[j] * rstd * gg + bb;
        if (OUT_BF16) { u32x2 w; w.x = pk2(o[0], o[1]); w.y = pk2(o[2], o[3]); ((u32x2*)dst)[lane + 64 * j] = w; }
        else ((f32x4*)dst)[lane + 64 * j] = o;
    }
}

__device__ __forceinline__ void tr_item(const float* W, int ldw, int src_col0, int k0, bf16* WT, int K, int dst_row0, LAS float* scr, int lane) {
#pragma unroll 8
    for (int i = 0; i < 32; ++i) { const int kk = 2 * i + (lane >> 5); scr[kk * 33 + (lane & 31)] = W[(size_t)(k0 + kk) * ldw + src_col0 + (lane & 31)]; }
    LDS_WAIT(); asm volatile("" ::: "memory");
    const int c = lane & 7;
#pragma unroll
    for (int j = 0; j < 4; ++j) { const int n = (lane >> 3) + 8 * j; const LAS float* s = scr + (8 * c) * 33 + n;
        u32x4 o; o.x = pk2(s[0 * 33], s[1 * 33]); o.y = pk2(s[2 * 33], s[3 * 33]); o.z = pk2(s[4 * 33], s[5 * 33]); o.w = pk2(s[6 * 33], s[7 * 33]);
        *(u32x4*)(WT + (size_t)(dst_row0 + n) * K + k0 + 8 * c) = o; }
    LDS_WAIT(); asm volatile("" ::: "memory");
}

constexpr int VPITCH = 136;
constexpr int VS_OFF = 0, VM_OFF = 15 * 64 * VPITCH, RPB_OFF = VM_OFF + 16 * VPITCH, MB_OFF = RPB_OFF + 1920;
static_assert(MB_OFF + 64 <= LDS_BYTES, "attention LDS");
__device__ __forceinline__ bf16x8 ldv8(const LAS unsigned char* p, int o0, int o1, int o2, int o3, int o4, int o5, int o6, int o7) {
    bf16x8 a;
    a[0] = *(const LAS short*)(p + o0); a[1] = *(const LAS short*)(p + o1); a[2] = *(const LAS short*)(p + o2); a[3] = *(const LAS short*)(p + o3);
    a[4] = *(const LAS short*)(p + o4); a[5] = *(const LAS short*)(p + o5); a[6] = *(const LAS short*)(p + o6); a[7] = *(const LAS short*)(p + o7);
    return a;
}
__device__ __forceinline__ void attn_wave_item(LAS unsigned char* lds, const bf16* PROJ, bf16* MIX, int seqbase, int h, int r, int rs, int rsA, int qb, bool is_meta, int lane) {
    const int i = lane & 15, kq = lane >> 4;
    int c_lane, cb, qrow;
    if (is_meta) { c_lane = 0; cb = 0; qrow = seqbase + i; }
    else { c_lane = 16 * qb + i; cb = qb == 0 ? 0 : qb == 1 ? 8 : qb == 2 ? 24 : 32; qrow = seqbase + 16 + r * 64 + 16 * qb + i; }
    const int cs = min(max(c_lane - 8, 0), 48);
    const bf16* qp = PROJ + (size_t)qrow * NIN + 1024 + h * 64 + 8 * kq;
    const bf16x8 q0 = *(const bf16x8*)qp, q1 = *(const bf16x8*)(qp + 32);
    f32x4 S[17];
    const bf16* kbase = PROJ + (size_t)(seqbase + 16 + rs * 64 + cb + i) * NIN + 2048 + h * 64 + 8 * kq;
#pragma unroll
    for (int blk = 0; blk < 16; ++blk) { const int kr = blk >> 1, half = blk & 1;
        const bf16* kp = kbase + (size_t)(kr * 64 + 16 * half) * NIN;
        const bf16x8 k0 = *(const bf16x8*)kp, k1 = *(const bf16x8*)(kp + 32);
        f32x4 z = {0.f, 0.f, 0.f, 0.f};
        z = __builtin_amdgcn_mfma_f32_16x16x32_bf16(k0, q0, z, 0, 0, 0);
        S[blk] = __builtin_amdgcn_mfma_f32_16x16x32_bf16(k1, q1, z, 0, 0, 0); }
    { const bf16* kp = PROJ + (size_t)(seqbase + i) * NIN + 2048 + h * 64 + 8 * kq;
        const bf16x8 k0 = *(const bf16x8*)kp, k1 = *(const bf16x8*)(kp + 32);
        f32x4 z = {0.f, 0.f, 0.f, 0.f};
        z = __builtin_amdgcn_mfma_f32_16x16x32_bf16(k0, q0, z, 0, 0, 0);
        S[16] = __builtin_amdgcn_mfma_f32_16x16x32_bf16(k1, q1, z, 0, 0, 0); }
    const LAS float* rpbL = (const LAS float*)(lds + RPB_OFF); const LAS float* mbL = (const LAS float*)(lds + MB_OFF);
    float mx = -1e30f;
#pragma unroll
    for (int blk = 0; blk < 16; ++blk) { const int kr = blk >> 1, half = blk & 1; const int dr = rs + kr - r + 7;
#pragma unroll
        for (int jj = 0; jj < 4; ++jj) { const int kc = cb + 16 * half + 4 * kq + jj; const bool valid = (kc >= cs) && (kc < cs + 16);
            const int dc = min(max(kc - c_lane + 15, 0), 30);
            const float sc = S[blk][jj] * 0.125f + rpbL[dr * 31 + dc];
            S[blk][jj] = valid ? sc : -1e30f; mx = fmaxf(mx, S[blk][jj]); } }
#pragma unroll
    for (int jj = 0; jj < 4; ++jj) { S[16][jj] = S[16][jj] * 0.125f + mbL[4 * kq + jj]; mx = fmaxf(mx, S[16][jj]); }
    mx = fmaxf(mx, __shfl_xor(mx, 16)); mx = fmaxf(mx, __shfl_xor(mx, 32));
    float sum = 0.f;
#pragma unroll
    for (int blk = 0; blk < 17; ++blk)
#pragma unroll
        for (int jj = 0; jj < 4; ++jj) { const float p = __expf(S[blk][jj] - mx); S[blk][jj] = p; sum += p; }
    sum += __shfl_xor(sum, 16); sum += __shfl_xor(sum, 32);
    const float inv = 1.f / sum;
    f32x4 O[4];
#pragma unroll
    for (int d0 = 0; d0 < 4; ++d0) O[d0] = (f32x4){0.f, 0.f, 0.f, 0.f};
    const LAS unsigned char* vb = lds + VS_OFF + ((rs - rsA) * 64 + cb + 4 * kq) * VPITCH + i * 2;
#pragma unroll
    for (int kr = 0; kr < 8; ++kr) {
        const f32x4 pa = S[2 * kr] * inv, pb = S[2 * kr + 1] * inv;
        u32x4 pw; pw.x = pk2(pa[0], pa[1]); pw.y = pk2(pa[2], pa[3]); pw.z = pk2(pb[0], pb[1]); pw.w = pk2(pb[2], pb[3]);
        const bf16x8 B = __builtin_bit_cast(bf16x8, pw);
        const LAS unsigned char* vr = vb + kr * 64 * VPITCH;
#pragma unroll
        for (int d0 = 0; d0 < 4; ++d0) {
            const bf16x8 A = ldv8(vr + d0 * 32, 0, VPITCH, 2 * VPITCH, 3 * VPITCH, 16 * VPITCH, 17 * VPITCH, 18 * VPITCH, 19 * VPITCH);
            O[d0] = __builtin_amdgcn_mfma_f32_16x16x32_bf16(A, B, O[d0], 0, 0, 0); }
    }
    { const f32x4 pa = S[16] * inv; u32x4 pw; pw.x = pk2(pa[0], pa[1]); pw.y = pk2(pa[2], pa[3]); pw.z = 0u; pw.w = 0u;
        const bf16x8 B = __builtin_bit_cast(bf16x8, pw);
        const LAS unsigned char* vr = lds + VM_OFF + (4 * kq) * VPITCH + i * 2;
#pragma unroll
        for (int d0 = 0; d0 < 4; ++d0) {
            bf16x8 A = ldv8(vr + d0 * 32, 0, VPITCH, 2 * VPITCH, 3 * VPITCH, 0, VPITCH, 2 * VPITCH, 3 * VPITCH);
            O[d0] = __builtin_amdgcn_mfma_f32_16x16x32_bf16(A, B, O[d0], 0, 0, 0); }
    }
    bf16* op = MIX + (size_t)qrow * DM + 1024 + h * 64 + 4 * kq;
#pragma unroll
    for (int d0 = 0; d0 < 4; ++d0) { u32x2 w; w.x = pk2(O[d0][0], O[d0][1]); w.y = pk2(O[d0][2], O[d0][3]); *(u32x2*)(op + 16 * d0) = w; }
}


__device__ __forceinline__ float tile16(LAS float* red, const bf16* A, size_t lda, const bf16* Bt, size_t ldb, int K, int tid, int wave, int lane) {
    const int i = lane & 15, kq = lane >> 4, kw = K >> 3;
    f32x4 acc = {0.f, 0.f, 0.f, 0.f};
    const bf16* ap = A + (size_t)i * lda + wave * kw + 8 * kq; const bf16* bp = Bt + (size_t)i * ldb + wave * kw + 8 * kq;
    for (int k = 0; k < kw; k += 32) acc = __builtin_amdgcn_mfma_f32_16x16x32_bf16(*(const bf16x8*)(ap + k), *(const bf16x8*)(bp + k), acc, 0, 0, 0);
    *(LAS f32x4*)(red + (wave * 64 + lane) * 4) = acc;
    __syncthreads();
    float v = 0.f;
    if (tid < 256) { const int row = tid >> 4, col = tid & 15, sl = col + 16 * (row >> 2), reg = row & 3;
#pragma unroll
        for (int w = 0; w < 8; ++w) v += red[(w * 64 + sl) * 4 + reg]; }
    __syncthreads();
    return v;
}

#ifndef REPS
#define REPS 1,1,1,1,1,1,1,1
#endif
constexpr int kReps[8] = {REPS};

__global__ void __launch_bounds__(512) fwd_mega(Args a) {
    extern __shared__ __attribute__((aligned(16))) unsigned char lds_raw[];
    LAS unsigned char* lds = (LAS unsigned char*)lds_raw;
    cg::grid_group grid = cg::this_grid();
    const int tid = threadIdx.x, lane = tid & 63, wave = __builtin_amdgcn_readfirstlane(tid >> 6);
    const int G = gridDim.x, bx = blockIdx.x;
    unsigned char* ws = a.ws;
    bf16* WinT = (bf16*)(ws + WS_WIN); bf16* WoutT = (bf16*)(ws + WS_WOUT); bf16* WupT = (bf16*)(ws + WS_WUP); bf16* WdnT = (bf16*)(ws + WS_WDN);
    float* SIDE = (float*)(ws + WS_SIDE);
    bf16* H1 = (bf16*)(ws + WS_H1); bf16* MIX = H1; bf16* H0 = (bf16*)(ws + WS_H0); bf16* PROJ = (bf16*)(ws + WS_PROJ); bf16* ACT = (bf16*)(ws + WS_ACT);

    _Pragma("unroll") for (int rep_ = 0; rep_ < kReps[0]; ++rep_)
    {
        LAS float* At = (LAS float*)lds;
        for (int it = bx; it < 256; it += G) {
            const int g = it >> 6, k0 = (it & 63) * 32;
            for (int idx = tid; idx < 32 * 64; idx += 512) { const int row = idx >> 6, c4 = idx & 63;
                *(LAS f32x4*)(At + row * 256 + c4 * 4) = *(const f32x4*)(a.w_in + (size_t)(k0 + row) * NIN + g * 256 + c4 * 4); }
            __syncthreads();
            const int e = tid & 255, kh = tid >> 8;
            float acc[16];
#pragma unroll
            for (int kk = 0; kk < 16; ++kk) acc[kk] = 0.f;
            const float* wp = a.w_pool + (size_t)g * 65536 + e;
            for (int c = 0; c < 256; c += 4) {
                const float p0 = wp[(c + 0) * 256], p1 = wp[(c + 1) * 256], p2 = wp[(c + 2) * 256], p3 = wp[(c + 3) * 256];
#pragma unroll
                for (int kk = 0; kk < 16; ++kk) { const f32x4 av = *(const LAS f32x4*)(At + (kh * 16 + kk) * 256 + c);
                    acc[kk] += (av[0] * p0 + av[1] * p1) + (av[2] * p2 + av[3] * p3); }
            }
            u32x4 o0, o1;
            o0.x = pk2(acc[0], acc[1]); o0.y = pk2(acc[2], acc[3]); o0.z = pk2(acc[4], acc[5]); o0.w = pk2(acc[6], acc[7]);
            o1.x = pk2(acc[8], acc[9]); o1.y = pk2(acc[10], acc[11]); o1.z = pk2(acc[12], acc[13]); o1.w = pk2(acc[14], acc[15]);
            bf16* dst = WinT + (size_t)(g * 256 + e) * DM + k0 + kh * 16;
            *(u32x4*)dst = o0; *(u32x4*)(dst + 8) = o1;
            __syncthreads();
        }
        LAS float* scr = (LAS float*)(lds + wave * 8448);
        const int gw = bx * 8 + wave, NGW = G * 8;
        constexpr int I_IN = 32 * 96, I_OUT = 32 * 64, I_UP = 32 * 344, I_DN = 86 * 64;
        for (int it = gw; it < I_IN + I_OUT + I_UP + I_DN; it += NGW) {
            int r = it;
            if (r < I_IN) { const int kb = r / 96, nb = r % 96; tr_item(a.w_in, NIN, 1024 + 32 * nb, 64 * kb, WinT, DM, 1024 + 32 * nb, scr, lane); continue; } r -= I_IN;
            if (r < I_OUT) { const int kb = r / 64, nb = r % 64; tr_item(a.w_out, DM, 32 * nb, 64 * kb, WoutT, DM, 32 * nb, scr, lane); continue; } r -= I_OUT;
            if (r < I_UP) { const int kb = r / 344, nb = r % 344; const int d0 = 32 * nb, j = d0 >> 8, idx = d0 & 255;
                const int sc0 = idx < 128 ? 128 * j + idx : DFF + 128 * j + idx - 128;
                tr_item(a.w_up, NUP, sc0, 64 * kb, WupT, DM, d0, scr, lane); continue; } r -= I_UP;
            { const int kb = r / 64, nb = r % 64; tr_item(a.w_down, DM, 32 * nb, 64 * kb, WdnT, DFF, 32 * nb, scr, lane); }
        }
        for (int R = gw; R < R_TOT; R += NGW) {
            const int s = seq_of_row(R), t = R - seq_start(s);
            const float* src;
            if (t < 16) src = a.meta_tokens + (size_t)t * DM;
            else { const int gr = grid_start(s) + t - 16; src = gr < 8192 ? a.x_prompt + (size_t)gr * DM : a.x_sample + (size_t)(gr - 8192) * DM; }
            ln_row<true>(src, a.ln_in_g, a.ln_in_b, H0 + (size_t)R * DM, lane);
        }
    }
    grid.sync();

    _Pragma("unroll") for (int rep_ = 0; rep_ < kReps[1]; ++rep_)
    {
        for (int task = bx; task < 256; task += G) {
            const float v = tile16((LAS float*)lds, H0, DM, WinT + (size_t)task * 16 * DM, DM, DM, tid, wave, lane);
            if (tid < 256) { const int m = tid >> 4, n = task * 16 + (tid & 15); const unsigned short hv = (unsigned short)(pk2(v, 0.f) & 0xffffu);
#pragma unroll
                for (int sq = 0; sq < 4; ++sq) PROJ[(size_t)(seq_start(sq) + m) * NIN + n] = hv; }
        }
        pg8::Gemm g{H0, WinT, 0, 0, DM}; pg8::StaticOrder S; S.init(96 * 256, NIN, G, bx);
        pg8::EpiBf16<pg8::RMGrid> E{PROJ, NIN};
        pg8::gemm_phase<pg8::EpiBf16<pg8::RMGrid>, pg8::RMGrid, pg8::StaticOrder, true, true>(lds, g, S, E);
    }
    grid.sync();

    _Pragma("unroll") for (int rep_ = 0; rep_ < kReps[2]; ++rep_)
    {
        for (int item = bx; item < 768; item += G) {
            const int cc = item >> 4, h = item & 15;
            const int s = cc < 8 ? 0 : cc < 16 ? 1 : cc < 32 ? 2 : 3;
            const int cidx = cc < 8 ? cc : cc < 16 ? cc - 8 : cc < 32 ? cc - 16 : cc - 32;
            const int rows = s < 2 ? 64 : 128, seqbase = seq_start(s);
            const int r0 = 8 * cidx;
            const int rsA = min(max(r0 - 4, 0), rows - 8), rsB = min(max(r0 + 3, 0), rows - 8), nrows = rsB + 8 - rsA;
            {   u32x4 vv[15]; const int kmax = nrows * 64 - 1;
#pragma unroll
                for (int itr = 0; itr < 15; ++itr) { const int idx = tid + 512 * itr, key = min(idx >> 3, kmax), part = idx & 7;
                    vv[itr] = *(const u32x4*)(PROJ + (size_t)(seqbase + 16 + rsA * 64 + key) * NIN + 3072 + h * 64 + part * 8); }
#pragma unroll
                for (int itr = 0; itr < 15; ++itr) { const int idx = tid + 512 * itr, key = idx >> 3, part = idx & 7;
                    LAS unsigned char* d = lds + VS_OFF + key * VPITCH + part * 16;
                    *(LAS u32x2*)d = (u32x2){vv[itr].x, vv[itr].y}; *(LAS u32x2*)(d + 8) = (u32x2){vv[itr].z, vv[itr].w}; } }
            if (tid < 128) { const int key = tid >> 3, part = tid & 7;
                const u32x4 v = *(const u32x4*)(PROJ + (size_t)(seqbase + key) * NIN + 3072 + h * 64 + part * 8);
                LAS unsigned char* d = lds + VM_OFF + key * VPITCH + part * 16;
                *(LAS u32x2*)d = (u32x2){v.x, v.y}; *(LAS u32x2*)(d + 8) = (u32x2){v.z, v.w}; }
            for (int idx = tid; idx < 465; idx += 512) ((LAS float*)(lds + RPB_OFF))[idx] = a.rpb[h * 465 + idx];
            if (tid < 16) ((LAS float*)(lds + MB_OFF))[tid] = a.meta_bias[h * 16 + tid];
            __syncthreads();
            const int nwi = 32 + (cidx == 0 ? 1 : 0);
            for (int wi = wave; wi < nwi; wi += 8) {
                if (wi < 32) { const int r = r0 + (wi >> 2), rs = min(max(r - 4, 0), rows - 8);
                    attn_wave_item(lds, PROJ, MIX, seqbase, h, r, rs, rsA, wi & 3, false, lane); }
                else attn_wave_item(lds, PROJ, MIX, seqbase, h, 0, 0, rsA, 0, true, lane);
            }
            __syncthreads();
        }
        for (int it = bx; it < R_TOT / 4; it += G) {
            const int g = wave & 3, R = it * 4 + (wave >> 2) * 2 + (lane >> 5), vec = g * 32 + (lane & 31);
            const int s = seq_of_row(R), st = seq_start(s), t = R - st, L = seq_len(s);
            float sum[8];
#pragma unroll
            for (int j = 0; j < 8; ++j) sum[j] = 0.f;
            const bf16* ub = PROJ + (size_t)st * NIN + vec * 8;
#define POOL_ACC(W) { u32x4 pv_[W]; float wg_[W]; _Pragma("unroll") for (int j = 0; j < W; ++j) { const int tt = t - W / 2 + j; wg_[j] = (tt >= 0 && tt < L) ? 1.f : 0.f; \
                pv_[j] = *(const u32x4*)(ub + (size_t)min(max(tt, 0), L - 1) * NIN); } \
              _Pragma("unroll") for (int j = 0; j < W; ++j) { const u32x4 v = pv_[j]; const float wq = wg_[j]; \
                sum[0] += wq * __uint_as_float(v.x << 16); sum[1] += wq * __uint_as_float(v.x & 0xffff0000u); sum[2] += wq * __uint_as_float(v.y << 16); sum[3] += wq * __uint_as_float(v.y & 0xffff0000u); \
                sum[4] += wq * __uint_as_float(v.z << 16); sum[5] += wq * __uint_as_float(v.z & 0xffff0000u); sum[6] += wq * __uint_as_float(v.w << 16); sum[7] += wq * __uint_as_float(v.w & 0xffff0000u); } }
            if (g == 0) POOL_ACC(2) else if (g == 1) POOL_ACC(4) else if (g == 2) POOL_ACC(8) else POOL_ACC(16)
#undef POOL_ACC
            const int w = 2 << g, lo = max(t - (w >> 1), 0), hi = min(t + (w >> 1), L);
            const u32x4 uv = *(const u32x4*)(ub + (size_t)t * NIN);
            const float ic = 1.f / (float)(hi - lo);
            const f32x4 ps0 = *(const f32x4*)(a.pool_scale + vec * 8), ps1 = *(const f32x4*)(a.pool_scale + vec * 8 + 4);
            float o[8];
            o[0] = (sum[0] * ic - __uint_as_float(uv.x << 16)) * ps0[0]; o[1] = (sum[1] * ic - __uint_as_float(uv.x & 0xffff0000u)) * ps0[1];
            o[2] = (sum[2] * ic - __uint_as_float(uv.y << 16)) * ps0[2]; o[3] = (sum[3] * ic - __uint_as_float(uv.y & 0xffff0000u)) * ps0[3];
            o[4] = (sum[4] * ic - __uint_as_float(uv.z << 16)) * ps1[0]; o[5] = (sum[5] * ic - __uint_as_float(uv.z & 0xffff0000u)) * ps1[1];
            o[6] = (sum[6] * ic - __uint_as_float(uv.w << 16)) * ps1[2]; o[7] = (sum[7] * ic - __uint_as_float(uv.w & 0xffff0000u)) * ps1[3];
            u32x4 ov; ov.x = pk2(o[0], o[1]); ov.y = pk2(o[2], o[3]); ov.z = pk2(o[4], o[5]); ov.w = pk2(o[6], o[7]);
            *(u32x4*)(MIX + (size_t)R * DM + vec * 8) = ov;
        }
    }
    grid.sync();

    _Pragma("unroll") for (int rep_ = 0; rep_ < kReps[3]; ++rep_)
    {
        for (int task = bx; task < 512; task += G) {
            const int sq = task & 3, cbk = task >> 2, rb = seq_start(sq);
            const float v = tile16((LAS float*)lds, MIX + (size_t)rb * DM, DM, WoutT + (size_t)cbk * 16 * DM, DM, DM, tid, wave, lane);
            if (tid < 256) { const int m = tid >> 4, n = cbk * 16 + (tid & 15);
                SIDE[(size_t)(sq * 16 + m) * DM + n] = v + ALPHA * pg8::bf2f(H0[(size_t)(rb + m) * DM + n]); }
        }
        pg8::Gemm g{MIX, WoutT, 0, 0, DM}; pg8::StaticOrder S; S.init(96 * 256, DM, G, bx);
        pg8::EpiRes<1> E{H0, a.out, SIDE};
        pg8::gemm_phase<pg8::EpiRes<1>, pg8::RMGrid, pg8::StaticOrder, true, true>(lds, g, S, E);
    }
    grid.sync();
    _Pragma("unroll") for (int rep_ = 0; rep_ < kReps[4]; ++rep_)
    {
        const int gw = bx * 8 + wave, NGW = G * 8;
        for (int R = gw; R < R_TOT; R += NGW) {
            const int s = seq_of_row(R), t = R - seq_start(s);
            const float* src = (t < 16) ? SIDE + (size_t)(s * 16 + t) * DM : a.out + (size_t)(grid_start(s) + t - 16) * DM;
            ln_row<true>(src, a.ln1_g, a.ln1_b, H1 + (size_t)R * DM, lane);
        }
    }
    grid.sync();
    _Pragma("unroll") for (int rep_ = 0; rep_ < kReps[5]; ++rep_)
    {
        pg8::Gemm g{H1, WupT, 0, 0, DM}; pg8::StaticOrder S; S.init(98 * 256, NUP, G, bx);
        pg8::EpiConvGate E{ACT, a.b_up, a.conv_w, a.conv_b, (LAS float*)(lds + XCH_OFF)};
        pg8::gemm_phase<pg8::EpiConvGate, pg8::RMUp, pg8::StaticOrder, true, true>(lds, g, S, E);
    }
    grid.sync();
    _Pragma("unroll") for (int rep_ = 0; rep_ < kReps[6]; ++rep_)
    {
        pg8::Gemm g{ACT, WdnT, 0, 0, DFF}; pg8::StaticOrder S; S.init(96 * 256, DM, G, bx);
        pg8::EpiRes<1> E{H1, a.out, SIDE};
        pg8::gemm_phase<pg8::EpiRes<1>, pg8::RMGrid, pg8::StaticOrder, true, true>(lds, g, S, E);
    }
    grid.sync();
    {
        const int gw = bx * 8 + wave, NGW = G * 8;
        for (int rep_ = 0; rep_ < kReps[7]; ++rep_) { float* dstb = (rep_ == kReps[7] - 1) ? a.out : (float*)(ws + WS_PROJ);
        for (int R = gw; R < G_TOT; R += NGW) ln_row<false>(a.out + (size_t)R * DM, a.ln2_g, a.ln2_b, dstb + (size_t)R * DM, lane); }
    }
}

extern "C" void kernel_launch(void* const* d_in, const int* in_sizes, int n_in, void* d_out, int out_size, void* d_ws, size_t ws_size, hipStream_t stream) {
    static int grid = 0;
    if (grid == 0) {
        int dev = 0, cus = 0, per = 0;
        if (n_in != 20 || out_size != G_TOT * DM || ws_size < WS_END) { fprintf(stderr, "kernel_launch: unexpected shapes (n_in %d out %d ws %zu)\n", n_in, out_size, ws_size); grid = -1; return; }
        (void)hipGetDevice(&dev); (void)hipDeviceGetAttribute(&cus, hipDeviceAttributeMultiprocessorCount, dev);
        (void)hipFuncSetAttribute((const void*)fwd_mega, hipFuncAttributeMaxDynamicSharedMemorySize, LDS_BYTES);
        (void)hipOccupancyMaxActiveBlocksPerMultiprocessor(&per, (const void*)fwd_mega, 512, LDS_BYTES);
        if (per < 1) per = 1;
        grid = cus * per;
        (void)hipGetLastError();
    }
    if (grid < 0) return;
    Args a{};
    const float** p = (const float**)&a;
    for (int i = 0; i < 20; ++i) p[i] = (const float*)d_in[i];
    a.out = (float*)d_out; a.ws = (unsigned char*)d_ws;
    void* args[] = {&a};
    hipError_t e = hipLaunchCooperativeKernel((const void*)fwd_mega, dim3(grid), dim3(512), args, LDS_BYTES, stream);
    if (e != hipSuccess) fprintf(stderr, "cooperative launch failed: %s (grid %d)\n", hipGetErrorString(e), grid);
}
```

```cpp
#define REPS 1,1,1,1,1,1,1,1,1,1
#include <hip/hip_runtime.h>
#include <hip/hip_cooperative_groups.h>
#include <cstdio>
#include <cstdint>
namespace cg = cooperative_groups;

constexpr int DM = 2048, NIN = 4096, DFF = 5504, NUP = 2 * DFF;
constexpr int R_TOT = 24640;
constexpr int G_TOT = 24576;
constexpr float LN_EPS = 1e-5f;
constexpr float ALPHA = 1.189207115002721f;
__device__ __forceinline__ int seq_of_row(int R) { return (R >= 4112) + (R >= 8224) + (R >= 16432); }
__device__ __forceinline__ int seq_start(int s) { return s == 0 ? 0 : s == 1 ? 4112 : s == 2 ? 8224 : 16432; }
__device__ __forceinline__ int seq_len(int s) { return s < 2 ? 4112 : 8208; }
__device__ __forceinline__ int grid_start(int s) { return s == 0 ? 0 : s == 1 ? 4096 : s == 2 ? 8192 : 16384; }

constexpr size_t MiB = 1u << 20;
constexpr size_t WS_WIN = 0, WS_WOUT = 16 * MiB, WS_WUP = 24 * MiB, WS_WDN = 67 * MiB, WS_SIDE = 89 * MiB;
constexpr size_t WS_H1 = 90 * MiB + 4096;
constexpr size_t WS_H0 = 189 * MiB, WS_PROJ = 287 * MiB, WS_ACT = 189 * MiB, WS_END = 481 * MiB;

constexpr int LDS_BYTES = 147456;
constexpr int XCH_OFF = 131072;
namespace pg8 {
#define PG8_LAS __attribute__((address_space(3)))
typedef unsigned short bf16_t;
typedef short bf16x8 __attribute__((ext_vector_type(8)));
typedef float f32x4 __attribute__((ext_vector_type(4)));
typedef unsigned u32x4 __attribute__((ext_vector_type(4)));
constexpr int BM = 256, BK = 64, HALF = 128, HTB = HALF * BK * 2  , STAGE_BYTES = 8 * HTB, NXCD = 8, WGM = 8;

__host__ __device__ __forceinline__ int lds_byte(int r, int c) { const int st = (r >> 4) * 2 + (c >> 5), rr = r & 15, cc = c & 31, ob = rr * 64 + cc * 2; return st * 1024 + (ob ^ (((ob >> 9) & 1) << 5)); }
__host__ __device__ __forceinline__ void stage_rc(int b, int& R, int& C) { const int st = b / 1024, sb = b % 1024, swz = sb ^ (((sb >> 9) & 1) << 5); R = (st >> 1) * 16 + swz / 64; C = (st & 1) * 32 + (swz % 64) / 2; }
__host__ __device__ __forceinline__ int perm32(int rho) { const int n = rho >> 4, i = rho & 15; return 8 * (i >> 2) + 4 * n + (i & 3); }

struct Unit { int pm, pn; };
struct Gemm { const bf16_t* A; const bf16_t* Bt; int M, N, K; };

struct StaticOrder {
    int nM, nN, nwg, G, c;
    __host__ __device__ void init(int M, int N, int G_, int c_) { nM = M / BM; nN = N / BM; nwg = nM * nN; G = G_; c = c_; }
    __host__ __device__ bool next(int i, Unit& u) const {
        const long L = (long)i * G + c; if (L >= nwg) return false;
        int wgid = (int)L; { const int q = nwg / NXCD, r = nwg % NXCD, xcd = wgid % NXCD, off = wgid / NXCD; wgid = (xcd < r ? xcd * (q + 1) : r * (q + 1) + (xcd - r) * q) + off; }
        const int nig = WGM * nN, gid = wgid / nig, fm = gid * WGM, gsz = (nM - fm) < WGM ? (nM - fm) : WGM;
        u.pm = fm + ((wgid % nig) % gsz); u.pn = (wgid % nig) / gsz; return true;
    }
    __device__ __forceinline__ void a_ready(const Unit&) const {}
    __device__ __forceinline__ void done(const Unit&) const {}
};

__device__ __forceinline__ unsigned cvt_pk_bf16(float lo, float hi) { unsigned r; asm volatile("v_cvt_pk_bf16_f32 %0, %1, %2" : "=v"(r) : "v"(lo), "v"(hi)); return r; }
typedef float f32x2 __attribute__((ext_vector_type(2)));
__device__ __forceinline__ f32x2 gelu_pk(f32x2 v) {
    const f32x2 av = __builtin_elementwise_abs(v), d = av * 0.2316418882f + 1.0f;
    f32x2 t; t.x = __builtin_amdgcn_rcpf(d.x); t.y = __builtin_amdgcn_rcpf(d.y);
    f32x2 q = t * 0.5307027145f + (-0.7265760135f); q = q * t + 0.7107068705f; q = q * t + (-0.142248368f); q = q * t + 0.127414796f; q = q * t;
    const f32x2 s = (v * v) * (-0.72134752044f);
    f32x2 e; e.x = __builtin_amdgcn_exp2f(s.x); e.y = __builtin_amdgcn_exp2f(s.y);
    const f32x2 m = v * (q * e), r = v - m;
    f32x2 o; o.x = v.x < 0.f ? m.x : r.x; o.y = v.y < 0.f ? m.y : r.y; return o;
}

struct RMNat  { static __device__ __forceinline__ int arow(int pm) { return pm * 256; } };
struct RMUp   { static __device__ __forceinline__ int arow(int pm) { return pm * 254 - 1; } };
struct RMGrid { static __device__ __forceinline__ int arow(int pm) { return pm * 256 + 16 * (1 + (pm >= 16) + (pm >= 32) + (pm >= 64)); } };

__device__ __forceinline__ float bf2f(unsigned short b) { return __uint_as_float((unsigned)b << 16); }

template <class RM> struct EpiBf16 {
    static constexpr bool PERM = true, AFTER_DRAIN = false;
    bf16_t* O; int ldc;
    __device__ __forceinline__ void operator()(const f32x4 (&acc)[2][2][4][2], const Unit& u, int wr, int wc, int fr, int fq) const {
        const int row0 = RM::arow(u.pm) + wr * 64 + fr; const int col0 = u.pn * BM + wc * 32 + 8 * fq;
#pragma unroll
        for (int ai = 0; ai < 2; ++ai)
#pragma unroll
            for (int m = 0; m < 4; ++m) { bf16_t* rowp = O + (size_t)(row0 + ai * HALF + m * 16) * ldc + col0;
#pragma unroll
                for (int bj = 0; bj < 2; ++bj) { const f32x4 v0 = acc[ai][bj][m][0], v1 = acc[ai][bj][m][1];
                    u32x4 w; w.x = cvt_pk_bf16(v0[0], v0[1]); w.y = cvt_pk_bf16(v0[2], v0[3]); w.z = cvt_pk_bf16(v1[0], v1[1]); w.w = cvt_pk_bf16(v1[2], v1[3]);
                    *(u32x4*)(rowp + bj * HALF) = w; } }
    }
};

template <int MODE> struct EpiRes {
    static constexpr bool PERM = true, AFTER_DRAIN = false;
    const bf16_t* Hres; float* out; float* side;
    __device__ __forceinline__ void operator()(const f32x4 (&acc)[2][2][4][2], const Unit& u, int wr, int wc, int fr, int fq) const {
        const int col0 = u.pn * BM + wc * 32 + 8 * fq;
#pragma unroll
        for (int ai = 0; ai < 2; ++ai)
#pragma unroll
            for (int m = 0; m < 4; ++m) {
                const int r = ai * HALF + wr * 64 + m * 16 + fr;
                float* dst; const bf16_t* res; bool ok = true;
                if (MODE == 0) { const int R = u.pm * BM + r; ok = R < R_TOT; const int s = seq_of_row(R), t = R - seq_start(s);
                    dst = (t < 16) ? side + (size_t)(s * 16 + t) * DM : out + (size_t)(grid_start(s) + t - 16) * DM; res = Hres + (size_t)R * DM; }
                else { dst = out + (size_t)(u.pm * BM + r) * DM; res = Hres + (size_t)(RMGrid::arow(u.pm) + r) * DM; }
                if (ok) {
#pragma unroll
                    for (int bj = 0; bj < 2; ++bj) {
                        const u32x4 hv = *(const u32x4*)(res + col0 + bj * HALF);
                        f32x4 h0, h1;
                        h0[0] = __uint_as_float(hv.x << 16); h0[1] = __uint_as_float(hv.x & 0xffff0000u); h0[2] = __uint_as_float(hv.y << 16); h0[3] = __uint_as_float(hv.y & 0xffff0000u);
                        h1[0] = __uint_as_float(hv.z << 16); h1[1] = __uint_as_float(hv.z & 0xffff0000u); h1[2] = __uint_as_float(hv.w << 16); h1[3] = __uint_as_float(hv.w & 0xffff0000u);
                        *(f32x4*)(dst + col0 + bj * HALF) = acc[ai][bj][m][0] + h0 * ALPHA;
                        *(f32x4*)(dst + col0 + bj * HALF + 4) = acc[ai][bj][m][1] + h1 * ALPHA; } }
            }
    }
};

__device__ __forceinline__ float dppf(float old, float src, const int ctrl_sel) {
    const int o = __float_as_int(old), s = __float_as_int(src); int r;
    if (ctrl_sel == 0) r = __builtin_amdgcn_update_dpp(o, s, 0x111, 0xf, 0xf, false);
    else if (ctrl_sel == 1) r = __builtin_amdgcn_update_dpp(o, s, 0x101, 0xf, 0xf, false);
    else if (ctrl_sel == 2) r = __builtin_amdgcn_update_dpp(o, s, 0x121, 0xf, 0xf, false);
    else r = __builtin_amdgcn_update_dpp(o, s, 0x12f, 0xf, 0xf, false);
    return __int_as_float(r);
}
__device__ __forceinline__ f32x4 lds_rd128_pinned(const PG8_LAS float* p) { f32x4 v; asm volatile("ds_read_b128 %0, %1\n\ts_waitcnt lgkmcnt(0)" : "=v"(v) : "v"((unsigned)(uintptr_t)p) : "memory"); return v; }
struct EpiConvGate {
    static constexpr bool PERM = true, AFTER_DRAIN = false;
    bf16_t* ACT; const float* b_up; const float* conv_w; const float* conv_b; PG8_LAS float* X;
    __device__ __forceinline__ void operator()(f32x4 (&acc)[2][2][4][2], const Unit& u, int wr, int wc, int fr, int fq) const {
        const int lc0 = wc * 32 + 8 * fq, ca0 = u.pn * HALF + lc0;
#pragma unroll
        for (int bj = 0; bj < 2; ++bj)
#pragma unroll
            for (int n = 0; n < 2; ++n) { const f32x4 bv = *(const f32x4*)(b_up + bj * DFF + ca0 + 4 * n);
#pragma unroll
                for (int ai = 0; ai < 2; ++ai)
#pragma unroll
                    for (int m = 0; m < 4; ++m) acc[ai][bj][m][n] += bv; }
        if (fr == 0) {
#pragma unroll
            for (int ai = 0; ai < 2; ++ai)
#pragma unroll
                for (int bj = 0; bj < 2; ++bj)
#pragma unroll
                    for (int n = 0; n < 2; ++n) *(PG8_LAS f32x4*)(X + (((ai * 2 + wr) * 2 + 0) * 256 + bj * HALF + lc0 + 4 * n)) = acc[ai][bj][0][n];
        }
        if (fr == 15) {
#pragma unroll
            for (int ai = 0; ai < 2; ++ai)
#pragma unroll
                for (int bj = 0; bj < 2; ++bj)
#pragma unroll
                    for (int n = 0; n < 2; ++n) *(PG8_LAS f32x4*)(X + (((ai * 2 + wr) * 2 + 1) * 256 + bj * HALF + lc0 + 4 * n)) = acc[ai][bj][3][n];
        }
        asm volatile("s_waitcnt lgkmcnt(0)" ::: "memory"); __builtin_amdgcn_s_barrier(); asm volatile("" ::: "memory");
        const int Rt = 254 * u.pm - 1;
#pragma unroll
        for (int n = 0; n < 2; ++n) {
            f32x4 w0[2], w1[2], w2[2], cbv[2];
#pragma unroll
            for (int bj = 0; bj < 2; ++bj) { const int ch = bj * DFF + ca0 + 4 * n;
                w0[bj] = *(const f32x4*)(conv_w + ch); w1[bj] = *(const f32x4*)(conv_w + NUP + ch); w2[bj] = *(const f32x4*)(conv_w + 2 * NUP + ch); cbv[bj] = *(const f32x4*)(conv_b + ch); }
#pragma unroll
            for (int ai = 0; ai < 2; ++ai)
#pragma unroll
                for (int m = 0; m < 4; ++m) {
                    const int r = ai * HALF + wr * 64 + m * 16 + fr, R = Rt + r;
                    const bool zp = (R == 0) | (R == 4112) | (R == 8224) | (R == 16432);
                    const bool zn = (R == 4111) | (R == 8223) | (R == 16431) | (R == 24639);
                    f32x4 z[2];
#pragma unroll
                    for (int bj = 0; bj < 2; ++bj) {
                        const f32x4 cur = acc[ai][bj][m][n]; f32x4 ep, en;
                        const int chk = ai * 2 + wr;
                        if (m > 0) { const f32x4 pb = acc[ai][bj][m > 0 ? m - 1 : 0][n];
#pragma unroll
                            for (int e = 0; e < 4; ++e) ep[e] = dppf(0.f, pb[e], 2); }
                        else { const int pc = chk > 0 ? chk - 1 : 0; ep = lds_rd128_pinned(X + ((pc * 2 + 1) * 256 + bj * HALF + lc0 + 4 * n)); }
                        if (m < 3) { const f32x4 nb = acc[ai][bj][m < 3 ? m + 1 : 3][n];
#pragma unroll
                            for (int e = 0; e < 4; ++e) en[e] = dppf(0.f, nb[e], 3); }
                        else { const int nc = chk < 3 ? chk + 1 : 3; en = lds_rd128_pinned(X + ((nc * 2 + 0) * 256 + bj * HALF + lc0 + 4 * n)); }
                        f32x4 pv, nv;
#pragma unroll
                        for (int e = 0; e < 4; ++e) { pv[e] = dppf(ep[e], cur[e], 0); nv[e] = dppf(en[e], cur[e], 1); pv[e] = zp ? 0.f : pv[e]; nv[e] = zn ? 0.f : nv[e]; }
                        z[bj] = w0[bj] * pv + w1[bj] * cur + w2[bj] * nv + cbv[bj];
                    }
                    const f32x2 g0 = gelu_pk((f32x2){z[1][0], z[1][1]}), g1 = gelu_pk((f32x2){z[1][2], z[1][3]});
                    unsigned o0 = cvt_pk_bf16(z[0][0] * g0.x, z[0][1] * g0.y), o1 = cvt_pk_bf16(z[0][2] * g1.x, z[0][3] * g1.y);
                    if (r >= 1 && r <= 254 && R < R_TOT) { typedef unsigned u32x2v __attribute__((ext_vector_type(2))); u32x2v w; w.x = o0; w.y = o1;
                        *(u32x2v*)(ACT + (size_t)R * DFF + ca0 + 4 * n) = w; }
                }
        }
    }
};

template <class Epi, class RM, class Sched, bool ALIGN_EPI = false, bool SP2 = false>
__device__ __forceinline__ void gemm_phase(PG8_LAS unsigned char* lds, const Gemm g, const Sched& S, const Epi& E) {
    int tid_ = threadIdx.x; asm volatile("" : "+v"(tid_));
    const int tid = tid_, wid = __builtin_amdgcn_readfirstlane(tid >> 6), lane = tid & 63, wr = wid >> 2, wc = wid & 3, fr = lane & 15, fq = lane >> 4;
    const int K = g.K, nt = K / BK;
    unsigned voffA[2], voffB[2];
#pragma unroll
    for (int i = 0; i < 2; ++i) { int R, C; stage_rc(tid * 16 + i * 8192, R, C); const int Rb = Epi::PERM ? ((R & ~31) + perm32(R & 31)) : R;
        voffA[i] = (unsigned)(R * K + C) * 2u; voffB[i] = (unsigned)(Rb * K + C) * 2u; }
    const size_t kstep = (size_t)(BK * 2);
    const size_t hstep = (size_t)HALF * K * 2;
    const size_t tstep = 2 * hstep; const ptrdiff_t rowb = (ptrdiff_t)K * 2;
    const unsigned ldsw = (unsigned)wid * 1024u;
    const int aoff = lds_byte(wr * 64 + fr, fq * 8), boff = lds_byte(wc * 32 + fr, fq * 8);
#define PG8_SA(b, h) (((b) * 2 + (h)) * HTB)
#define PG8_SB(b, h) ((4 + (b) * 2 + (h)) * HTB)
#define PG8_STAGE(bufoff, gbase, voff) do { _Pragma("unroll") for (int _i = 0; _i < 2; ++_i) \
        __builtin_amdgcn_global_load_lds((const unsigned*)((const char*)(gbase) + (voff)[_i]), (PG8_LAS unsigned*)(lds + (bufoff) + ldsw + _i * 8192), 16, 0, 0); } while (0)
#define PG8_LDA(dst, b, h) do { _Pragma("unroll") for (int m = 0; m < 4; ++m) _Pragma("unroll") for (int k = 0; k < 2; ++k) dst[m][k] = *(const PG8_LAS bf16x8*)(lds + PG8_SA(b, h) + aoff + m * 2048 + k * 1024); } while (0)
#define PG8_LDB(dst, b, h) do { _Pragma("unroll") for (int n = 0; n < 2; ++n) _Pragma("unroll") for (int k = 0; k < 2; ++k) dst[n][k] = *(const PG8_LAS bf16x8*)(lds + PG8_SB(b, h) + boff + n * 2048 + k * 1024); } while (0)
#define PG8_MMA(ai, bj, At, Bt) do { __builtin_amdgcn_s_setprio(1); _Pragma("unroll") for (int m = 0; m < 4; ++m) _Pragma("unroll") for (int n = 0; n < 2; ++n) _Pragma("unroll") for (int k = 0; k < 2; ++k) \
        acc[ai][bj][m][n] = __builtin_amdgcn_mfma_f32_16x16x32_bf16(Bt[n][k], At[m][k], acc[ai][bj][m][n], 0, 0, 0); __builtin_amdgcn_s_setprio(0); } while (0)
#define PG8_WAIT_V(n) asm volatile("s_waitcnt vmcnt(" #n ")" ::: "memory")
#define PG8_WAIT_L(n) asm volatile("s_waitcnt lgkmcnt(" #n ")" ::: "memory")
#define PG8_BAR __builtin_amdgcn_s_barrier()
#define PG8_SCHED __builtin_amdgcn_sched_barrier(0)
    Unit cur, nxt; int ui = 0;
    if (!S.next(0, cur)) return;
    f32x4 acc[2][2][4][2];
#pragma unroll
    for (int a = 0; a < 2; ++a)
#pragma unroll
        for (int b = 0; b < 2; ++b)
#pragma unroll
            for (int m = 0; m < 4; ++m)
#pragma unroll
                for (int n = 0; n < 2; ++n) acc[a][b][m][n] = (f32x4){0.f, 0.f, 0.f, 0.f};
    bf16x8 At[4][2], B0[2][2], B1[2][2];
    const char* cA = (const char*)g.A + (ptrdiff_t)RM::arow(cur.pm) * rowb; const char* cB = (const char*)g.Bt + (size_t)cur.pn * tstep;
    S.a_ready(cur);
    if constexpr (SP2) {
        PG8_STAGE(PG8_SB(0, 0), cB, voffB); PG8_STAGE(PG8_SB(0, 1), cB + hstep, voffB); PG8_STAGE(PG8_SA(0, 0), cA, voffA); PG8_STAGE(PG8_SA(0, 1), cA + hstep, voffA);
        if (wr == 1) PG8_BAR;
        PG8_WAIT_V(2); PG8_BAR;
        PG8_STAGE(PG8_SB(1, 0), cB + kstep, voffB); PG8_STAGE(PG8_SA(1, 0), cA + kstep, voffA); PG8_STAGE(PG8_SB(1, 1), cB + hstep + kstep, voffB);
        PG8_WAIT_V(6); PG8_BAR;
    } else {
        PG8_STAGE(PG8_SB(0, 0), cB, voffB); PG8_STAGE(PG8_SA(0, 0), cA, voffA); PG8_STAGE(PG8_SB(0, 1), cB + hstep, voffB); PG8_STAGE(PG8_SA(0, 1), cA + hstep, voffA);
        if (wr == 1) PG8_BAR;
        PG8_WAIT_V(4); PG8_BAR;
        PG8_STAGE(PG8_SB(1, 0), cB + kstep, voffB); PG8_STAGE(PG8_SA(1, 0), cA + kstep, voffA); PG8_STAGE(PG8_SB(1, 1), cB + hstep + kstep, voffB);
        PG8_WAIT_V(6); PG8_BAR;
    }
    for (;;) {
        const bool has_next = S.next(ui + 1, nxt);
        const char* nA = has_next ? (const char*)g.A + (ptrdiff_t)RM::arow(nxt.pm) * rowb : cA; const char* nB = has_next ? (const char*)g.Bt + (size_t)nxt.pn * tstep : cB;
        for (int t = 0; t < nt; t += 2) {
            const bool last = (t == nt - 2);
            const char* a1 = cA + (size_t)(t + 1) * kstep;
            const char* a2 = last ? nA : cA + (size_t)(t + 2) * kstep; const char* b2 = last ? nB : cB + (size_t)(t + 2) * kstep;
            const char* a3 = a2 + kstep; const char* b3 = b2 + kstep;
            if (last && has_next) S.a_ready(nxt);
            if constexpr (SP2) {
            PG8_LDB(B0, 0, 0); PG8_LDB(B1, 0, 1); PG8_SCHED; PG8_LDA(At, 0, 0); PG8_STAGE(PG8_SA(1, 1), a1 + hstep, voffA);
            PG8_WAIT_V(8); PG8_WAIT_L(0); PG8_BAR; PG8_MMA(0, 0, At, B0); PG8_MMA(0, 1, At, B1); PG8_BAR; PG8_SCHED;
            PG8_LDA(At, 0, 1); PG8_STAGE(PG8_SB(0, 0), b2, voffB); PG8_STAGE(PG8_SB(0, 1), b2 + hstep, voffB); PG8_STAGE(PG8_SA(0, 0), a2, voffA);
            PG8_WAIT_V(8); PG8_WAIT_L(0); PG8_BAR; PG8_MMA(1, 0, At, B0); PG8_MMA(1, 1, At, B1); PG8_BAR; PG8_SCHED;
            PG8_LDB(B0, 1, 0); PG8_LDB(B1, 1, 1); PG8_SCHED; PG8_LDA(At, 1, 0); PG8_STAGE(PG8_SA(0, 1), a2 + hstep, voffA);
            PG8_WAIT_V(8); PG8_WAIT_L(0); PG8_BAR; PG8_MMA(0, 0, At, B0); PG8_MMA(0, 1, At, B1); PG8_BAR; PG8_SCHED;
            PG8_LDA(At, 1, 1); PG8_STAGE(PG8_SB(1, 0), b3, voffB); PG8_STAGE(PG8_SB(1, 1), b3 + hstep, voffB); PG8_STAGE(PG8_SA(1, 0), a3, voffA);
            PG8_WAIT_V(8); PG8_WAIT_L(0); PG8_BAR; PG8_MMA(1, 0, At, B0); PG8_MMA(1, 1, At, B1); PG8_BAR; PG8_SCHED;
            } else {
            PG8_LDB(B0, 0, 0); PG8_SCHED; PG8_LDA(At, 0, 0); PG8_STAGE(PG8_SA(1, 1), a1 + hstep, voffA);
            PG8_WAIT_L(8); PG8_BAR; PG8_WAIT_L(0); PG8_MMA(0, 0, At, B0); PG8_BAR; PG8_SCHED;
            PG8_LDB(B1, 0, 1); PG8_STAGE(PG8_SB(0, 0), b2, voffB);
            PG8_BAR; PG8_WAIT_L(0); PG8_MMA(0, 1, At, B1); PG8_BAR;
            PG8_LDA(At, 0, 1); PG8_STAGE(PG8_SA(0, 0), a2, voffA);
            PG8_BAR; PG8_WAIT_L(0); PG8_MMA(1, 0, At, B0); PG8_BAR; PG8_SCHED;
            PG8_STAGE(PG8_SB(0, 1), b2 + hstep, voffB);
            PG8_WAIT_V(6); PG8_BAR; PG8_MMA(1, 1, At, B1); PG8_BAR;
            PG8_LDB(B0, 1, 0); PG8_SCHED; PG8_LDA(At, 1, 0); PG8_STAGE(PG8_SA(0, 1), a2 + hstep, voffA);
            PG8_WAIT_L(8); PG8_BAR; PG8_WAIT_L(0); PG8_MMA(0, 0, At, B0); PG8_BAR; PG8_SCHED;
            PG8_LDB(B1, 1, 1); PG8_STAGE(PG8_SB(1, 0), b3, voffB);
            PG8_BAR; PG8_WAIT_L(0); PG8_MMA(0, 1, At, B1); PG8_BAR;
            PG8_LDA(At, 1, 1); PG8_STAGE(PG8_SA(1, 0), a3, voffA);
            PG8_BAR; PG8_WAIT_L(0); PG8_MMA(1, 0, At, B0); PG8_BAR; PG8_SCHED;
            PG8_STAGE(PG8_SB(1, 1), b3 + hstep, voffB);
            PG8_WAIT_V(6); PG8_BAR; PG8_MMA(1, 1, At, B1); PG8_BAR;
            }
        }
        if constexpr (ALIGN_EPI) { if (wr == 0) PG8_BAR; }
        if constexpr (!Epi::AFTER_DRAIN) { E(acc, cur, wr, wc, fr, fq); S.done(cur); }
        if (!has_next) break;
#pragma unroll
        for (int a = 0; a < 2; ++a)
#pragma unroll
            for (int b = 0; b < 2; ++b)
#pragma unroll
                for (int m = 0; m < 4; ++m)
#pragma unroll
                    for (int n = 0; n < 2; ++n) acc[a][b][m][n] = (f32x4){0.f, 0.f, 0.f, 0.f};
        cur = nxt; cA = nA; cB = nB; ++ui;
        if constexpr (ALIGN_EPI) { if (wr == 1) PG8_BAR; }
    }
    PG8_WAIT_V(0);
    if constexpr (!ALIGN_EPI) { if (wr == 0) PG8_BAR; }
    PG8_BAR;
    if constexpr (Epi::AFTER_DRAIN) { E.fused(acc, cur, wr, wc, fr, fq, lds, wid, lane); S.done(cur); }
#undef PG8_SA
#undef PG8_SB
#undef PG8_STAGE
#undef PG8_LDA
#undef PG8_LDB
#undef PG8_MMA
#undef PG8_WAIT_V
#undef PG8_WAIT_L
#undef PG8_BAR
#undef PG8_SCHED
}
}
#define LAS __attribute__((address_space(3)))
typedef unsigned short bf16;
typedef float f32x4 __attribute__((ext_vector_type(4)));
typedef short bf16x8 __attribute__((ext_vector_type(8)));
typedef unsigned u32x4 __attribute__((ext_vector_type(4)));
typedef unsigned u32x2 __attribute__((ext_vector_type(2)));
#define LDS_WAIT() asm volatile("s_waitcnt lgkmcnt(0)" ::: "memory")
__device__ __forceinline__ unsigned pk2(float lo, float hi) { return pg8::cvt_pk_bf16(lo, hi); }

struct Args {
    const float *x_prompt, *x_sample, *meta_tokens, *ln_in_g, *ln_in_b, *w_in, *w_pool, *pool_scale, *rpb, *meta_bias, *w_out, *ln1_g, *ln1_b,
                *w_up, *b_up, *conv_w, *conv_b, *w_down, *ln2_g, *ln2_b;
    float* out; unsigned char* ws;
};

__device__ __forceinline__ float wave_sum(float v) {
#pragma unroll
    for (int o = 1; o < 64; o <<= 1) v += __shfl_xor(v, o);
    return v;
}
template <bool OUT_BF16> __device__ __forceinline__ void ln_row(const float* src, const float* g, const float* b, void* dst, int lane) {
    const f32x4* xr = (const f32x4*)src + lane;
    f32x4 v[8]; float s = 0.f;
#pragma unroll
    for (int j = 0; j < 8; ++j) { v[j] = xr[64 * j]; s += (v[j][0] + v[j][1]) + (v[j][2] + v[j][3]); }
    const float mean = wave_sum(s) * (1.f / DM); float s2 = 0.f;
#pragma unroll
    for (int j = 0; j < 8; ++j) { v[j] = v[j] - mean; s2 += (v[j][0] * v[j][0] + v[j][1] * v[j][1]) + (v[j][2] * v[j][2] + v[j][3] * v[j][3]); }
    const float rstd = 1.f / sqrtf(wave_sum(s2) * (1.f / DM) + LN_EPS);
#pragma unroll
    for (int j = 0; j < 8; ++j) {
        const f32x4 gg = ((const f32x4*)g)[lane + 64 * j], bb = ((const f32x4*)b)[lane + 64 * j];
        const f32x4 o = v[j] * rstd * gg + bb;
        if (OUT_BF16) { u32x2 w; w.x = pk2(o[0], o[1]); w.y = pk2(o[2], o[3]); ((u32x2*)dst)[lane + 64 * j] = w; }
        else ((f32x4*)dst)[lane + 64 * j] = o;
    }
}

__device__ __forceinline__ void tr_item(const float* W, int ldw, int src_col0, int k0, bf16* WT, int K, int dst_row0, LAS float* scr, int lane) {
#pragma unroll 8
    for (int i = 0; i < 32; ++i) { const int kk = 2 * i + (lane >> 5); scr[kk * 33 + (lane & 31)] = W[(size_t)(k0 + kk) * ldw + src_col0 + (lane & 31)]; }
    LDS_WAIT(); asm volatile("" ::: "memory");
    const int c = lane & 7;
#pragma unroll
    for (int j = 0; j < 4; ++j) { const int n = (lane >> 3) + 8 * j; const LAS float* s = scr + (8 * c) * 33 + n;
        u32x4 o; o.x = pk2(s[0 * 33], s[1 * 33]); o.y = pk2(s[2 * 33], s[3 * 33]); o.z = pk2(s[4 * 33], s[5 * 33]); o.w = pk2(s[6 * 33], s[7 * 33]);
        *(u32x4*)(WT + (size_t)(dst_row0 + n) * K + k0 + 8 * c) = o; }
    LDS_WAIT(); asm volatile("" ::: "memory");
}

constexpr int VPITCH = 144;
constexpr int VS_OFF = 0, VM_OFF = 15 * 64 * VPITCH, RPB_OFF = VM_OFF + 16 * VPITCH, MB_OFF = RPB_OFF + 1920;
static_assert(MB_OFF + 64 <= LDS_BYTES, "attention LDS");
__device__ __forceinline__ bf16x8 ldv8(const LAS unsigned char* p, int o0, int o1, int o2, int o3, int o4, int o5, int o6, int o7) {
    bf16x8 a;
    a[0] = *(const LAS short*)(p + o0); a[1] = *(const LAS short*)(p + o1); a[2] = *(const LAS short*)(p + o2); a[3] = *(const LAS short*)(p + o3);
    a[4] = *(const LAS short*)(p + o4); a[5] = *(const LAS short*)(p + o5); a[6] = *(const LAS short*)(p + o6); a[7] = *(const LAS short*)(p + o7);
    return a;
}
__device__ __forceinline__ void attn_wave_item(LAS unsigned char* lds, const bf16* PROJ, bf16* MIX, int seqbase, int h, int r, int rs, int rsA, int qb, bool is_meta, int lane) {
    const int i = lane & 15, kq = lane >> 4;
    int c_lane, cb, qrow;
    if (is_meta) { c_lane = 0; cb = 0; qrow = seqbase + i; }
    else { c_lane = 16 * qb + i; cb = qb == 0 ? 0 : qb == 1 ? 8 : qb == 2 ? 24 : 32; qrow = seqbase + 16 + r * 64 + 16 * qb + i; }
    const int cs = min(max(c_lane - 8, 0), 48);
    const bf16* qp = PROJ + (size_t)qrow * NIN + 1024 + h * 64 + 8 * kq;
    const bf16x8 q0 = *(const bf16x8*)qp, q1 = *(const bf16x8*)(qp + 32);
    f32x4 S[17];
    const bf16* kbase = PROJ + (size_t)(seqbase + 16 + rs * 64 + cb + i) * NIN + 2048 + h * 64 + 8 * kq;
#pragma unroll
    for (int blk = 0; blk < 16; ++blk) { const int kr = blk >> 1, half = blk & 1;
        const bf16* kp = kbase + (size_t)(kr * 64 + 16 * half) * NIN;
        const bf16x8 k0 = *(const bf16x8*)kp, k1 = *(const bf16x8*)(kp + 32);
        f32x4 z = {0.f, 0.f, 0.f, 0.f};
        z = __builtin_amdgcn_mfma_f32_16x16x32_bf16(k0, q0, z, 0, 0, 0);
        S[blk] = __builtin_amdgcn_mfma_f32_16x16x32_bf16(k1, q1, z, 0, 0, 0); }
    { const bf16* kp = PROJ + (size_t)(seqbase + i) * NIN + 2048 + h * 64 + 8 * kq;
        const bf16x8 k0 = *(const bf16x8*)kp, k1 = *(const bf16x8*)(kp + 32);
        f32x4 z = {0.f, 0.f, 0.f, 0.f};
        z = __builtin_amdgcn_mfma_f32_16x16x32_bf16(k0, q0, z, 0, 0, 0);
        S[16] = __builtin_amdgcn_mfma_f32_16x16x32_bf16(k1, q1, z, 0, 0, 0); }
    const LAS float* rpbL = (const LAS float*)(lds + RPB_OFF); const LAS float* mbL = (const LAS float*)(lds + MB_OFF);
    float mx = -1e30f;
#pragma unroll
    for (int blk = 0; blk < 16; ++blk) { const int kr = blk >> 1, half = blk & 1; const int dr = rs + kr - r + 7;
#pragma unroll
        for (int jj = 0; jj < 4; ++jj) { const int kc = cb + 16 * half + 4 * kq + jj; const bool valid = (kc >= cs) && (kc < cs + 16);
            const int dc = min(max(kc - c_lane + 15, 0), 30);
            const float sc = S[blk][jj] * 0.125f + rpbL[dr * 31 + dc];
            S[blk][jj] = valid ? sc : -1e30f; mx = fmaxf(mx, S[blk][jj]); } }
#pragma unroll
    for (int jj = 0; jj < 4; ++jj) { S[16][jj] = S[16][jj] * 0.125f + mbL[4 * kq + jj]; mx = fmaxf(mx, S[16][jj]); }
    mx = fmaxf(mx, __shfl_xor(mx, 16)); mx = fmaxf(mx, __shfl_xor(mx, 32));
    float sum = 0.f;
#pragma unroll
    for (int blk = 0; blk < 17; ++blk)
#pragma unroll
        for (int jj = 0; jj < 4; ++jj) { const float p = __expf(S[blk][jj] - mx); S[blk][jj] = p; sum += p; }
    sum += __shfl_xor(sum, 16); sum += __shfl_xor(sum, 32);
    const float inv = 1.f / sum;
    f32x4 O[4];
#pragma unroll
    for (int d0 = 0; d0 < 4; ++d0) O[d0] = (f32x4){0.f, 0.f, 0.f, 0.f};
    typedef short v4i16_t __attribute__((ext_vector_type(4)));
#define VTR(p) __builtin_amdgcn_ds_read_tr16_b64_v4i16((LAS v4i16_t*)(p))
    const int tq = (lane & 15) >> 2, tp = lane & 3;
    LAS unsigned char* vb = lds + VS_OFF + ((rs - rsA) * 64 + cb + 4 * kq + tq) * VPITCH + 8 * tp;
#pragma unroll
    for (int kr = 0; kr < 8; ++kr) {
        const f32x4 pa = S[2 * kr] * inv, pb = S[2 * kr + 1] * inv;
        u32x4 pw; pw.x = pk2(pa[0], pa[1]); pw.y = pk2(pa[2], pa[3]); pw.z = pk2(pb[0], pb[1]); pw.w = pk2(pb[2], pb[3]);
        const bf16x8 B = __builtin_bit_cast(bf16x8, pw);
        LAS unsigned char* vr = vb + kr * 64 * VPITCH;
#pragma unroll
        for (int d0 = 0; d0 < 4; ++d0) {
            const v4i16_t lo = VTR(vr + d0 * 32), hi = VTR(vr + 16 * VPITCH + d0 * 32);
            const bf16x8 A = (bf16x8){lo[0], lo[1], lo[2], lo[3], hi[0], hi[1], hi[2], hi[3]};
            O[d0] = __builtin_amdgcn_mfma_f32_16x16x32_bf16(A, B, O[d0], 0, 0, 0); }
    }
    { const f32x4 pa = S[16] * inv; u32x4 pw; pw.x = pk2(pa[0], pa[1]); pw.y = pk2(pa[2], pa[3]); pw.z = 0u; pw.w = 0u;
        const bf16x8 B = __builtin_bit_cast(bf16x8, pw);
        LAS unsigned char* vr = lds + VM_OFF + (4 * kq + tq) * VPITCH + 8 * tp;
#pragma unroll
        for (int d0 = 0; d0 < 4; ++d0) {
            const v4i16_t lo = VTR(vr + d0 * 32);
            const bf16x8 A = (bf16x8){lo[0], lo[1], lo[2], lo[3], 0, 0, 0, 0};
            O[d0] = __builtin_amdgcn_mfma_f32_16x16x32_bf16(A, B, O[d0], 0, 0, 0); }
    }
#undef VTR
    bf16* op = MIX + (size_t)qrow * DM + 1024 + h * 64 + 4 * kq;
#pragma unroll
    for (int d0 = 0; d0 < 4; ++d0) { u32x2 w; w.x = pk2(O[d0][0], O[d0][1]); w.y = pk2(O[d0][2], O[d0][3]); *(u32x2*)(op + 16 * d0) = w; }
}


__device__ __forceinline__ float tile16(LAS float* red, const bf16* A, size_t lda, const bf16* Bt, size_t ldb, int K, int tid, int wave, int lane) {
    const int i = lane & 15, kq = lane >> 4, kw = K >> 3;
    f32x4 acc = {0.f, 0.f, 0.f, 0.f};
    const bf16* ap = A + (size_t)i * lda + wave * kw + 8 * kq; const bf16* bp = Bt + (size_t)i * ldb + wave * kw + 8 * kq;
    for (int k = 0; k < kw; k += 32) acc = __builtin_amdgcn_mfma_f32_16x16x32_bf16(*(const bf16x8*)(ap + k), *(const bf16x8*)(bp + k), acc, 0, 0, 0);
    *(LAS f32x4*)(red + (wave * 64 + lane) * 4) = acc;
    __syncthreads();
    float v = 0.f;
    if (tid < 256) { const int row = tid >> 4, col = tid & 15, sl = col + 16 * (row >> 2), reg = row & 3;
#pragma unroll
        for (int w = 0; w < 8; ++w) v += red[(w * 64 + sl) * 4 + reg]; }
    __syncthreads();
    return v;
}

#ifndef REPS
#define REPS 1,1,1,1,1,1,1,1,1,1
#endif
constexpr int kReps[10] = {REPS};

__global__ void __launch_bounds__(512) fwd_mega(Args a) {
    extern __shared__ __attribute__((aligned(16))) unsigned char lds_raw[];
    LAS unsigned char* lds = (LAS unsigned char*)lds_raw;
    cg::grid_group grid = cg::this_grid();
    const int tid = threadIdx.x, lane = tid & 63, wave = __builtin_amdgcn_readfirstlane(tid >> 6);
    const int G = gridDim.x, bx = blockIdx.x;
    unsigned char* ws = a.ws;
    bf16* WinT = (bf16*)(ws + WS_WIN); bf16* WoutT = (bf16*)(ws + WS_WOUT); bf16* WupT = (bf16*)(ws + WS_WUP); bf16* WdnT = (bf16*)(ws + WS_WDN);
    float* SIDE = (float*)(ws + WS_SIDE);
    bf16* H1 = (bf16*)(ws + WS_H1); bf16* MIX = H1; bf16* H0 = (bf16*)(ws + WS_H0); bf16* PROJ = (bf16*)(ws + WS_PROJ); bf16* ACT = (bf16*)(ws + WS_ACT);

    _Pragma("unroll") for (int rep_ = 0; rep_ < kReps[0]; ++rep_)
    {
        LAS float* At = (LAS float*)lds;
        for (int it = bx; it < 256; it += G) {
            const int g = it >> 6, k0 = (it & 63) * 32;
            for (int idx = tid; idx < 32 * 64; idx += 512) { const int row = idx >> 6, c4 = idx & 63;
                *(LAS f32x4*)(At + row * 256 + c4 * 4) = *(const f32x4*)(a.w_in + (size_t)(k0 + row) * NIN + g * 256 + c4 * 4); }
            __syncthreads();
            const int e = tid & 255, kh = tid >> 8;
            float acc[16];
#pragma unroll
            for (int kk = 0; kk < 16; ++kk) acc[kk] = 0.f;
            const float* wp = a.w_pool + (size_t)g * 65536 + e;
            for (int c = 0; c < 256; c += 4) {
                const float p0 = wp[(c + 0) * 256], p1 = wp[(c + 1) * 256], p2 = wp[(c + 2) * 256], p3 = wp[(c + 3) * 256];
#pragma unroll
                for (int kk = 0; kk < 16; ++kk) { const f32x4 av = *(const LAS f32x4*)(At + (kh * 16 + kk) * 256 + c);
                    acc[kk] += (av[0] * p0 + av[1] * p1) + (av[2] * p2 + av[3] * p3); }
            }
            u32x4 o0, o1;
            o0.x = pk2(acc[0], acc[1]); o0.y = pk2(acc[2], acc[3]); o0.z = pk2(acc[4], acc[5]); o0.w = pk2(acc[6], acc[7]);
            o1.x = pk2(acc[8], acc[9]); o1.y = pk2(acc[10], acc[11]); o1.z = pk2(acc[12], acc[13]); o1.w = pk2(acc[14], acc[15]);
            bf16* dst = WinT + (size_t)(g * 256 + e) * DM + k0 + kh * 16;
            *(u32x4*)dst = o0; *(u32x4*)(dst + 8) = o1;
            __syncthreads();
        }
        LAS float* scr = (LAS float*)(lds + wave * 8448);
        const int gw = bx * 8 + wave, NGW = G * 8;
        constexpr int I_IN = 32 * 96, I_OUT = 32 * 64, I_UP = 32 * 344, I_DN = 86 * 64;
        for (int it = gw; it < I_IN + I_OUT + I_UP + I_DN; it += NGW) {
            int r = it;
            if (r < I_IN) { const int kb = r / 96, nb = r % 96; tr_item(a.w_in, NIN, 1024 + 32 * nb, 64 * kb, WinT, DM, 1024 + 32 * nb, scr, lane); continue; } r -= I_IN;
            if (r < I_OUT) { const int kb = r / 64, nb = r % 64; tr_item(a.w_out, DM, 32 * nb, 64 * kb, WoutT, DM, 32 * nb, scr, lane); continue; } r -= I_OUT;
            if (r < I_UP) { const int kb = r / 344, nb = r % 344; const int d0 = 32 * nb, j = d0 >> 8, idx = d0 & 255;
                const int sc0 = idx < 128 ? 128 * j + idx : DFF + 128 * j + idx - 128;
                tr_item(a.w_up, NUP, sc0, 64 * kb, WupT, DM, d0, scr, lane); continue; } r -= I_UP;
            { const int kb = r / 64, nb = r % 64; tr_item(a.w_down, DM, 32 * nb, 64 * kb, WdnT, DFF, 32 * nb, scr, lane); }
        }
        for (int R = gw; R < R_TOT; R += NGW) {
            const int s = seq_of_row(R), t = R - seq_start(s);
            const float* src;
            if (t < 16) src = a.meta_tokens + (size_t)t * DM;
            else { const int gr = grid_start(s) + t - 16; src = gr < 8192 ? a.x_prompt + (size_t)gr * DM : a.x_sample + (size_t)(gr - 8192) * DM; }
            ln_row<true>(src, a.ln_in_g, a.ln_in_b, H0 + (size_t)R * DM, lane);
        }
    }
    grid.sync();

    _Pragma("unroll") for (int rep_ = 0; rep_ < kReps[1]; ++rep_)
    {
        for (int task = bx; task < 256; task += G) {
            const float v = tile16((LAS float*)lds, H0, DM, WinT + (size_t)task * 16 * DM, DM, DM, tid, wave, lane);
            if (tid < 256) { const int m = tid >> 4, n = task * 16 + (tid & 15); const unsigned short hv = (unsigned short)(pk2(v, 0.f) & 0xffffu);
#pragma unroll
                for (int sq = 0; sq < 4; ++sq) PROJ[(size_t)(seq_start(sq) + m) * NIN + n] = hv; }
        }
        pg8::Gemm g{H0, WinT, 0, 0, DM}; pg8::StaticOrder S; S.init(96 * 256, NIN, G, bx);
        pg8::EpiBf16<pg8::RMGrid> E{PROJ, NIN};
        pg8::gemm_phase<pg8::EpiBf16<pg8::RMGrid>, pg8::RMGrid, pg8::StaticOrder, true, true>(lds, g, S, E);
    }
    grid.sync();

    _Pragma("unroll") for (int rep_ = 0; rep_ < kReps[2]; ++rep_)
    {
        _Pragma("unroll") for (int rep2_ = 0; rep2_ < kReps[8]; ++rep2_)
        for (int item = bx; item < 768; item += G) {
            const int cc = item >> 4, h = item & 15;
            const int s = cc < 8 ? 0 : cc < 16 ? 1 : cc < 32 ? 2 : 3;
            const int cidx = cc < 8 ? cc : cc < 16 ? cc - 8 : cc < 32 ? cc - 16 : cc - 32;
            const int rows = s < 2 ? 64 : 128, seqbase = seq_start(s);
            const int r0 = 8 * cidx;
            const int rsA = min(max(r0 - 4, 0), rows - 8), rsB = min(max(r0 + 3, 0), rows - 8), nrows = rsB + 8 - rsA;
            {   u32x4 vv[15]; const int kmax = nrows * 64 - 1;
#pragma unroll
                for (int itr = 0; itr < 15; ++itr) { const int idx = tid + 512 * itr, key = min(idx >> 3, kmax), part = idx & 7;
                    vv[itr] = *(const u32x4*)(PROJ + (size_t)(seqbase + 16 + rsA * 64 + key) * NIN + 3072 + h * 64 + part * 8); }
#pragma unroll
                for (int itr = 0; itr < 15; ++itr) { const int idx = tid + 512 * itr, key = idx >> 3, part = idx & 7;
                    *(LAS u32x4*)(lds + VS_OFF + key * VPITCH + part * 16) = vv[itr]; } }
            if (tid < 128) { const int key = tid >> 3, part = tid & 7;
                const u32x4 v = *(const u32x4*)(PROJ + (size_t)(seqbase + key) * NIN + 3072 + h * 64 + part * 8);
                *(LAS u32x4*)(lds + VM_OFF + key * VPITCH + part * 16) = v; }
            for (int idx = tid; idx < 465; idx += 512) ((LAS float*)(lds + RPB_OFF))[idx] = a.rpb[h * 465 + idx];
            if (tid < 16) ((LAS float*)(lds + MB_OFF))[tid] = a.meta_bias[h * 16 + tid];
            __syncthreads();
            const int nwi = 32 + (cidx == 0 ? 1 : 0);
            for (int wi = wave; wi < nwi; wi += 8) {
                if (wi < 32) { const int r = r0 + (wi >> 2), rs = min(max(r - 4, 0), rows - 8);
                    attn_wave_item(lds, PROJ, MIX, seqbase, h, r, rs, rsA, wi & 3, false, lane); }
                else attn_wave_item(lds, PROJ, MIX, seqbase, h, 0, 0, rsA, 0, true, lane);
            }
            __syncthreads();
        }
        _Pragma("unroll") for (int rep3_ = 0; rep3_ < kReps[9]; ++rep3_)
        for (int it = bx; it < R_TOT / 4; it += G) {
            const int g = wave & 3, R = it * 4 + (wave >> 2) * 2 + (lane >> 5), vec = g * 32 + (lane & 31);
            const int s = seq_of_row(R), st = seq_start(s), t = R - st, L = seq_len(s);
            float sum[8];
#pragma unroll
            for (int j = 0; j < 8; ++j) sum[j] = 0.f;
            const bf16* ub = PROJ + (size_t)st * NIN + vec * 8;
#define POOL_ACC(W) { u32x4 pv_[W]; float wg_[W]; _Pragma("unroll") for (int j = 0; j < W; ++j) { const int tt = t - W / 2 + j; wg_[j] = (tt >= 0 && tt < L) ? 1.f : 0.f; \
                pv_[j] = *(const u32x4*)(ub + (size_t)min(max(tt, 0), L - 1) * NIN); } \
              _Pragma("unroll") for (int j = 0; j < W; ++j) { const u32x4 v = pv_[j]; const float wq = wg_[j]; \
                sum[0] += wq * __uint_as_float(v.x << 16); sum[1] += wq * __uint_as_float(v.x & 0xffff0000u); sum[2] += wq * __uint_as_float(v.y << 16); sum[3] += wq * __uint_as_float(v.y & 0xffff0000u); \
                sum[4] += wq * __uint_as_float(v.z << 16); sum[5] += wq * __uint_as_float(v.z & 0xffff0000u); sum[6] += wq * __uint_as_float(v.w << 16); sum[7] += wq * __uint_as_float(v.w & 0xffff0000u); } }
            if (g == 0) POOL_ACC(2) else if (g == 1) POOL_ACC(4) else if (g == 2) POOL_ACC(8) else POOL_ACC(16)
#undef POOL_ACC
            const int w = 2 << g, lo = max(t - (w >> 1), 0), hi = min(t + (w >> 1), L);
            const u32x4 uv = *(const u32x4*)(ub + (size_t)t * NIN);
            const float ic = 1.f / (float)(hi - lo);
            const f32x4 ps0 = *(const f32x4*)(a.pool_scale + vec * 8), ps1 = *(const f32x4*)(a.pool_scale + vec * 8 + 4);
            float o[8];
            o[0] = (sum[0] * ic - __uint_as_float(uv.x << 16)) * ps0[0]; o[1] = (sum[1] * ic - __uint_as_float(uv.x & 0xffff0000u)) * ps0[1];
            o[2] = (sum[2] * ic - __uint_as_float(uv.y << 16)) * ps0[2]; o[3] = (sum[3] * ic - __uint_as_float(uv.y & 0xffff0000u)) * ps0[3];
            o[4] = (sum[4] * ic - __uint_as_float(uv.z << 16)) * ps1[0]; o[5] = (sum[5] * ic - __uint_as_float(uv.z & 0xffff0000u)) * ps1[1];
            o[6] = (sum[6] * ic - __uint_as_float(uv.w << 16)) * ps1[2]; o[7] = (sum[7] * ic - __uint_as_float(uv.w & 0xffff0000u)) * ps1[3];
            u32x4 ov; ov.x = pk2(o[0], o[1]); ov.y = pk2(o[2], o[3]); ov.z = pk2(o[4], o[5]); ov.w = pk2(o[6], o[7]);
            *(u32x4*)(MIX + (size_t)R * DM + vec * 8) = ov;
        }
    }
    grid.sync();

    _Pragma("unroll") for (int rep_ = 0; rep_ < kReps[3]; ++rep_)
    {
        for (int task = bx; task < 512; task += G) {
            const int sq = task & 3, cbk = task >> 2, rb = seq_start(sq);
            const float v = tile16((LAS float*)lds, MIX + (size_t)rb * DM, DM, WoutT + (size_t)cbk * 16 * DM, DM, DM, tid, wave, lane);
            if (tid < 256) { const int m = tid >> 4, n = cbk * 16 + (tid & 15);
                SIDE[(size_t)(sq * 16 + m) * DM + n] = v + ALPHA * pg8::bf2f(H0[(size_t)(rb + m) * DM + n]); }
        }
        pg8::Gemm g{MIX, WoutT, 0, 0, DM}; pg8::StaticOrder S; S.init(96 * 256, DM, G, bx);
        pg8::EpiRes<1> E{H0, a.out, SIDE};
        pg8::gemm_phase<pg8::EpiRes<1>, pg8::RMGrid, pg8::StaticOrder, true, true>(lds, g, S, E);
    }
    grid.sync();
    _Pragma("unroll") for (int rep_ = 0; rep_ < kReps[4]; ++rep_)
    {
        const int gw = bx * 8 + wave, NGW = G * 8;
        for (int R = gw; R < R_TOT; R += NGW) {
            const int s = seq_of_row(R), t = R - seq_start(s);
            const float* src = (t < 16) ? SIDE + (size_t)(s * 16 + t) * DM : a.out + (size_t)(grid_start(s) + t - 16) * DM;
            ln_row<true>(src, a.ln1_g, a.ln1_b, H1 + (size_t)R * DM, lane);
        }
    }
    grid.sync();
    _Pragma("unroll") for (int rep_ = 0; rep_ < kReps[5]; ++rep_)
    {
        pg8::Gemm g{H1, WupT, 0, 0, DM}; pg8::StaticOrder S; S.init(98 * 256, NUP, G, bx);
        pg8::EpiConvGate E{ACT, a.b_up, a.conv_w, a.conv_b, (LAS float*)(lds + XCH_OFF)};
        pg8::gemm_phase<pg8::EpiConvGate, pg8::RMUp, pg8::StaticOrder, true, true>(lds, g, S, E);
    }
    grid.sync();
    _Pragma("unroll") for (int rep_ = 0; rep_ < kReps[6]; ++rep_)
    {
        pg8::Gemm g{ACT, WdnT, 0, 0, DFF}; pg8::StaticOrder S; S.init(96 * 256, DM, G, bx);
        pg8::EpiRes<1> E{H1, a.out, SIDE};
        pg8::gemm_phase<pg8::EpiRes<1>, pg8::RMGrid, pg8::StaticOrder, true, true>(lds, g, S, E);
    }
    grid.sync();
    {
        const int gw = bx * 8 + wave, NGW = G * 8;
        for (int rep_ = 0; rep_ < kReps[7]; ++rep_) { float* dstb = (rep_ == kReps[7] - 1) ? a.out : (float*)(ws + WS_PROJ);
        for (int R = gw; R < G_TOT; R += NGW) ln_row<false>(a.out + (size_t)R * DM, a.ln2_g, a.ln2_b, dstb + (size_t)R * DM, lane); }
    }
}

extern "C" void kernel_launch(void* const* d_in, const int* in_sizes, int n_in, void* d_out, int out_size, void* d_ws, size_t ws_size, hipStream_t stream) {
    static int grid = 0;
    if (grid == 0) {
        int dev = 0, cus = 0, per = 0;
        if (n_in != 20 || out_size != G_TOT * DM || ws_size < WS_END) { fprintf(stderr, "kernel_launch: unexpected shapes (n_in %d out %d ws %zu)\n", n_in, out_size, ws_size); grid = -1; return; }
        (void)hipGetDevice(&dev); (void)hipDeviceGetAttribute(&cus, hipDeviceAttributeMultiprocessorCount, dev);
        (void)hipFuncSetAttribute((const void*)fwd_mega, hipFuncAttributeMaxDynamicSharedMemorySize, LDS_BYTES);
        (void)hipOccupancyMaxActiveBlocksPerMultiprocessor(&per, (const void*)fwd_mega, 512, LDS_BYTES);
        if (per < 1) per = 1;
        grid = cus * per;
        (void)hipGetLastError();
    }
    if (grid < 0) return;
    Args a{};
    const float** p = (const float**)&a;
    for (int i = 0; i < 20; ++i) p[i] = (const float*)d_in[i];
    a.out = (float*)d_out; a.ws = (unsigned char*)d_ws;
    void* args[] = {&a};
    hipError_t e = hipLaunchCooperativeKernel((const void*)fwd_mega, dim3(grid), dim3(512), args, LDS_BYTES, stream);
    if (e != hipSuccess) fprintf(stderr, "cooperative launch failed: %s (grid %d)\n", hipGetErrorString(e), grid);
}
```
